# Optimizing an MI355X kernel written in HIP

```python
import math
import jax, jax.numpy as jnp
from jax import lax
import numpy as np

D_MODEL = 1024
BATCH = 8
SEQ = 2048
DEPTH = 2

GRID_W = 64
CTX_LEN = 256
EPS = 1e-6
CHUNK = 128
D_A = D_MODEL
G_A = 8
D_B = D_MODEL
CONV_W = 3
D_C = D_MODEL // 2
S5_GROUP = 16
G_C = D_C // S5_GROUP
S5_STATE = 64
N_HEADS = 8
QK_NOPE = 64
QK_ROPE = 32
QK_HEAD = QK_NOPE + QK_ROPE
V_HEAD = 64
Q_LORA = 768
KV_LORA = 256
AXIS_PAIRS = QK_ROPE // 4
ROPE_BASE = 10000.0
Q_BLOCK = 128
N_GROUPS = 4
EXPERTS_PER_GROUP = 8
N_EXPERTS = N_GROUPS * EXPERTS_PER_GROUP
TOP_K = 2
D_EXPERT = 512

D_IN_AB = 2 * D_A + 3 * D_B
D_IN_CD = D_C + Q_LORA + KV_LORA + QK_ROPE
D_MIX_AB = D_A + D_B
D_MIX_CD = D_C + N_HEADS * V_HEAD

kernel_name = 'hybrid_gmlp_conv_s5_mla_hmoe_dit'


def rms(x):
    xf = x.astype(jnp.float32)
    return (xf * lax.rsqrt(jnp.mean(xf * xf, axis=-1, keepdims=True) + EPS)).astype(x.dtype)


def modulate(x, shift, scale):
    return rms(x) * (1 + scale) + shift


def chunk_spatial_gating(u, v, sgu_norm, sgu_w, sgu_b):
    b, l, _ = v.shape
    vc = (rms(v) * sgu_norm).reshape(b, l // CHUNK, CHUNK, G_A, D_A // G_A)
    s = jnp.einsum('gpq,bnqgc->bnpgc', sgu_w, vc) + sgu_b.T[None, None, :, :, None]
    return u * s.reshape(b, l, D_A)


def short_conv(z, conv_w):
    return lax.conv_general_dilated(
        z, conv_w[:, None, :].astype(z.dtype), window_strides=(1,),
        padding=[(CONV_W // 2, CONV_W // 2)], dimension_numbers=('NWC', 'WIO', 'NWC'),
        feature_group_count=z.shape[-1])


def mixer_ab(h, w_in, sgu_norm, sgu_w, sgu_b, conv_w, w_out):
    z = h @ w_in
    u, v, gate_b, gate_c, xb = jnp.split(z, [D_A, 2 * D_A, 2 * D_A + D_B, 2 * D_A + 2 * D_B], axis=-1)
    y_a = chunk_spatial_gating(jax.nn.gelu(u), jax.nn.gelu(v), sgu_norm, sgu_w, sgu_b)
    y_b = gate_b * short_conv(gate_c * xb, conv_w)
    return jnp.concatenate([y_a, y_b], axis=-1) @ w_out


def cmul(ar, ai, br, bi):
    return ar * br - ai * bi, ar * bi + ai * br


def s5_discretise(a_re, a_im, log_dt, b_re, b_im):
    dt = jnp.exp(log_dt)[:, None]
    mag = jnp.exp(dt * a_re)
    ab_re, ab_im = mag * jnp.cos(dt * a_im), mag * jnp.sin(dt * a_im)
    den = a_re * a_re + a_im * a_im
    nr = ab_re - 1.0
    f_re = (nr * a_re + ab_im * a_im) / den
    f_im = (ab_im * a_re - nr * a_im) / den
    bb_re, bb_im = cmul(f_re[..., None], f_im[..., None], b_re, b_im)
    return ab_re, ab_im, bb_re, bb_im


def s5_scan(u, ab_re, ab_im, bb_re, bb_im, h0, reverse):
    bu_re = jnp.einsum('gpc,blgc->blgp', bb_re, u)
    bu_im = jnp.einsum('gpc,blgc->blgp', bb_im, u)
    if h0 is not None:
        first = -1 if reverse else 0
        i_re, i_im = cmul(ab_re, ab_im, h0[0], h0[1])
        bu_re = bu_re.at[:, first].add(i_re)
        bu_im = bu_im.at[:, first].add(i_im)
    shape = (1, u.shape[1]) + ab_re.shape
    a_re = jnp.broadcast_to(ab_re, shape)
    a_im = jnp.broadcast_to(ab_im, shape)

    def combine(e1, e2):
        a1r, a1i, b1r, b1i = e1
        a2r, a2i, b2r, b2i = e2
        ar, ai = cmul(a2r, a2i, a1r, a1i)
        br, bi = cmul(a2r, a2i, b1r, b1i)
        return ar, ai, br + b2r, bi + b2i

    _, _, h_re, h_im = lax.associative_scan(combine, (a_re, a_im, bu_re, bu_im), reverse=reverse, axis=1)
    return h_re, h_im


def s5_readout(c_re, c_im, h_re, h_im):
    return jnp.einsum('gcp,blgp->blgc', c_re, h_re) - jnp.einsum('gcp,blgp->blgc', c_im, h_im)


def s5_mixer(u_lat, u_ctx, a_re, a_im, log_dt, b_re, b_im, c_re, c_im, d_skip, w_glu, need_ctx_out):
    dtype = u_lat.dtype
    f = lambda t: t.astype(jnp.float32)
    ul = f(u_lat).reshape(u_lat.shape[0], u_lat.shape[1], G_C, S5_GROUP)
    uc = f(u_ctx).reshape(u_ctx.shape[0], u_ctx.shape[1], G_C, S5_GROUP)
    d = f(d_skip).reshape(G_C, S5_GROUP)
    y_l = ul * d
    y_c = uc * d if need_ctx_out else None
    for direction in range(2):
        rev = direction == 1
        ab_re, ab_im, bb_re, bb_im = s5_discretise(
            f(a_re[direction]), f(a_im[direction]), f(log_dt[direction]), f(b_re[direction]), f(b_im[direction]))
        hc_re, hc_im = s5_scan(uc, ab_re, ab_im, bb_re, bb_im, None, rev)
        end = 0 if rev else -1
        hl_re, hl_im = s5_scan(ul, ab_re, ab_im, bb_re, bb_im, (hc_re[:, end], hc_im[:, end]), rev)
        cr, ci = f(c_re[direction]), f(c_im[direction])
        y_l = y_l + s5_readout(cr, ci, hl_re, hl_im)
        if need_ctx_out:
            y_c = y_c + s5_readout(cr, ci, hc_re, hc_im)

    def glu(y):
        g = jax.nn.gelu(y.reshape(y.shape[0], y.shape[1], D_C)).astype(dtype)
        return g * jax.nn.sigmoid(g @ w_glu)

    return glu(y_l), (glu(y_c) if need_ctx_out else None)


def axial_angles(l):
    rows = l // GRID_W
    row = jnp.repeat(jnp.arange(rows, dtype=jnp.float32), GRID_W)
    col = jnp.tile(jnp.arange(GRID_W, dtype=jnp.float32), rows)
    inv_freq = ROPE_BASE ** (-jnp.arange(AXIS_PAIRS, dtype=jnp.float32) / AXIS_PAIRS)
    return row[:, None] * inv_freq, col[:, None] * inv_freq


def rotate(x, ang):
    cos = jnp.cos(ang)[None, :, None, :]
    sin = jnp.sin(ang)[None, :, None, :]
    xf = x.astype(jnp.float32)
    x1, x2 = xf[..., :AXIS_PAIRS], xf[..., AXIS_PAIRS:]
    return jnp.concatenate([x1 * cos - x2 * sin, x2 * cos + x1 * sin], axis=-1).astype(x.dtype)


def axial_rope(t, ang_row, ang_col):
    nope, r_row, r_col = jnp.split(t, [QK_NOPE, QK_NOPE + 2 * AXIS_PAIRS], axis=-1)
    return jnp.concatenate([nope, rotate(r_row, ang_row), rotate(r_col, ang_col)], axis=-1)


def mla_q(cq, q_norm, w_uq, qn_gain, angles):
    b, l, _ = cq.shape
    q = ((rms(cq) * q_norm) @ w_uq).reshape(b, l, N_HEADS, QK_HEAD)
    q = rms(q) * qn_gain
    return axial_rope(q, *angles) if angles is not None else q


def mla_kv(ckv, k_rope, kv_norm, w_uk, w_uv, kn_gain, angles):
    b, l, _ = ckv.shape
    ckv_n = rms(ckv) * kv_norm
    k_nope = (ckv_n @ w_uk).reshape(b, l, N_HEADS, QK_NOPE)
    v = (ckv_n @ w_uv).reshape(b, l, N_HEADS, V_HEAD)
    k_r = jnp.broadcast_to(k_rope[:, :, None, :], (b, l, N_HEADS, QK_ROPE))
    k = rms(jnp.concatenate([k_nope, k_r], axis=-1)) * kn_gain
    k = axial_rope(k, *angles) if angles is not None else k
    return k, v


def attend(q, k, v):
    s = jnp.einsum('bqhd,bkhd->bhqk', q, k).astype(jnp.float32) * (QK_HEAD ** -0.5)
    p = jax.nn.softmax(s, axis=-1).astype(v.dtype)
    return jnp.einsum('bhqk,bkhd->bqhd', p, v)


def blockwise_attend(q, k, v):
    b, l, h, d = q.shape
    qb = q.reshape(b, l // Q_BLOCK, Q_BLOCK, h, d).transpose(1, 0, 2, 3, 4)
    ob = lax.map(lambda qi: attend(qi, k, v), qb)
    return ob.transpose(1, 0, 2, 3, 4).reshape(b, l, h, v.shape[-1])


def mixer_cd(h, hc, w_in, a_re, a_im, log_dt, b_re, b_im, c_re, c_im, d_skip, w_glu,
             q_norm, kv_norm, w_uq, w_uk, w_uv, qn_gain, kn_gain, w_out, angles, need_ctx_out):
    idx = [D_C, D_C + Q_LORA, D_C + Q_LORA + KV_LORA]
    u_l, cq_l, ckv_l, kr_l = jnp.split(h @ w_in, idx, axis=-1)
    u_c, cq_c, ckv_c, kr_c = jnp.split(hc @ w_in, idx, axis=-1)
    s5_l, s5_c = s5_mixer(u_l, u_c, a_re, a_im, log_dt, b_re, b_im, c_re, c_im, d_skip, w_glu, need_ctx_out)
    k_c, v_c = mla_kv(ckv_c, kr_c, kv_norm, w_uk, w_uv, kn_gain, None)
    k_l, v_l = mla_kv(ckv_l, kr_l, kv_norm, w_uk, w_uv, kn_gain, angles)
    q_l = mla_q(cq_l, q_norm, w_uq, qn_gain, angles)
    o_l = blockwise_attend(q_l, jnp.concatenate([k_c, k_l], axis=1), jnp.concatenate([v_c, v_l], axis=1))
    b, l = h.shape[:2]
    y_l = jnp.concatenate([s5_l, o_l.reshape(b, l, N_HEADS * V_HEAD)], axis=-1) @ w_out
    if not need_ctx_out:
        return y_l, None
    q_c = mla_q(cq_c, q_norm, w_uq, qn_gain, None)
    o_c = attend(q_c, k_c, v_c)
    y_c = jnp.concatenate([s5_c, o_c.reshape(b, hc.shape[1], N_HEADS * V_HEAD)], axis=-1) @ w_out
    return y_l, y_c


def hier_moe(x, w_grp, b_grp, w_exp, b_exp, w_gate, w_up, w_down):
    shape = x.shape
    t = x.reshape(-1, shape[-1])
    n = t.shape[0]
    p_grp = jax.nn.softmax((t @ w_grp).astype(jnp.float32) + b_grp.astype(jnp.float32), axis=-1)
    p_top, grp = lax.top_k(p_grp, 1)
    e_logits = ((t @ w_exp).astype(jnp.float32) + b_exp.astype(jnp.float32)).reshape(n, N_GROUPS, EXPERTS_PER_GROUP)
    sel = jnp.take_along_axis(e_logits, jnp.broadcast_to(grp[:, :, None], (n, 1, EXPERTS_PER_GROUP)), axis=1)[:, 0]
    top_l, top_i = lax.top_k(sel, TOP_K)
    w_top = jax.nn.softmax(top_l, axis=-1) * p_top
    eid = grp * EXPERTS_PER_GROUP + top_i
    gates = jnp.sum(jax.nn.one_hot(eid, N_EXPERTS, dtype=jnp.float32) * w_top[..., None], axis=1).astype(t.dtype)
    y = jnp.zeros_like(t)
    for e in range(N_EXPERTS):
        he = jax.nn.silu(t @ w_gate[e]) * (t @ w_up[e])
        y = y + gates[:, e:e + 1] * (he @ w_down[e])
    return y.reshape(shape)


def setup_inputs(seed: int = 0) -> dict:
    key = jax.random.key(seed)
    ks = iter(jax.random.split(key, 48))
    nrm = lambda shape, scale: scale * jax.random.normal(next(ks), shape, jnp.float32)
    ne, no = (DEPTH + 1) // 2, DEPTH // 2
    D = D_MODEL
    n_idx = jnp.arange(S5_STATE, dtype=jnp.float32)
    return {
        'x': nrm((BATCH, SEQ, D), 1.0),
        'c': nrm((BATCH, D), 1.0),
        'ctx': nrm((BATCH, CTX_LEN, D), 1.0),
        'c_ctx': nrm((D,), 1.0),
        'ada_w': nrm((DEPTH, D, 6 * D), 0.5 * D ** -0.5),
        'ada_b': nrm((DEPTH, 6 * D), 0.02),
        'ab_w_in': nrm((ne, D, D_IN_AB), D ** -0.5),
        'sgu_norm': 1.0 + nrm((ne, D_A), 0.02),
        'sgu_w': nrm((ne, G_A, CHUNK, CHUNK), CHUNK ** -0.5),
        'sgu_b': 1.0 + nrm((ne, G_A, CHUNK), 0.02),
        'conv_w': nrm((ne, CONV_W, D_B), CONV_W ** -0.5),
        'ab_w_out': nrm((ne, D_MIX_AB, D), D_MIX_AB ** -0.5),
        'cd_w_in': nrm((no, D, D_IN_CD), D ** -0.5),
        's5_a_re': -0.5 + nrm((no, 2, G_C, S5_STATE), 0.01),
        's5_a_im': math.pi * n_idx + nrm((no, 2, G_C, S5_STATE), 0.01),
        's5_log_dt': jax.random.uniform(next(ks), (no, 2, G_C), jnp.float32, math.log(1e-3), math.log(1e-1)),
        's5_b_re': nrm((no, 2, G_C, S5_STATE, S5_GROUP), (2 * S5_GROUP) ** -0.5),
        's5_b_im': nrm((no, 2, G_C, S5_STATE, S5_GROUP), (2 * S5_GROUP) ** -0.5),
        's5_c_re': nrm((no, 2, G_C, S5_GROUP, S5_STATE), (S5_STATE / 2) ** -0.5),
        's5_c_im': nrm((no, 2, G_C, S5_GROUP, S5_STATE), (S5_STATE / 2) ** -0.5),
        's5_d': nrm((no, D_C), 1.0),
        's5_w_glu': nrm((no, D_C, D_C), D_C ** -0.5),
        'mla_q_norm': 1.0 + nrm((no, Q_LORA), 0.02),
        'mla_kv_norm': 1.0 + nrm((no, KV_LORA), 0.02),
        'mla_w_uq': nrm((no, Q_LORA, N_HEADS * QK_HEAD), Q_LORA ** -0.5),
        'mla_w_uk': nrm((no, KV_LORA, N_HEADS * QK_NOPE), KV_LORA ** -0.5),
        'mla_w_uv': nrm((no, KV_LORA, N_HEADS * V_HEAD), KV_LORA ** -0.5),
        'mla_qn_gain': 1.0 + nrm((no, QK_HEAD), 0.02),
        'mla_kn_gain': 1.0 + nrm((no, QK_HEAD), 0.02),
        'cd_w_out': nrm((no, D_MIX_CD, D), D_MIX_CD ** -0.5),
        'moe_w_grp': nrm((DEPTH, D, N_GROUPS), D ** -0.5),
        'moe_b_grp': nrm((DEPTH, N_GROUPS), 0.01),
        'moe_w_exp': nrm((DEPTH, D, N_EXPERTS), D ** -0.5),
        'moe_b_exp': nrm((DEPTH, N_EXPERTS), 0.01),
        'moe_w_gate': nrm((DEPTH, N_EXPERTS, D, D_EXPERT), D ** -0.5),
        'moe_w_up': nrm((DEPTH, N_EXPERTS, D, D_EXPERT), D ** -0.5),
        'moe_w_down': nrm((DEPTH, N_EXPERTS, D_EXPERT, D), D_EXPERT ** -0.5),
    }


def reference(x, c, ctx, c_ctx, ada_w, ada_b, ab_w_in, sgu_norm, sgu_w, sgu_b, conv_w, ab_w_out,
              cd_w_in, s5_a_re, s5_a_im, s5_log_dt, s5_b_re, s5_b_im, s5_c_re, s5_c_im, s5_d, s5_w_glu,
              mla_q_norm, mla_kv_norm, mla_w_uq, mla_w_uk, mla_w_uv, mla_qn_gain, mla_kn_gain, cd_w_out,
              moe_w_grp, moe_b_grp, moe_w_exp, moe_b_exp, moe_w_gate, moe_w_up, moe_w_down):
    angles = axial_angles(x.shape[1])
    xl, xc = x, ctx
    for i in range(DEPTH):
        last = i == DEPTH - 1
        j = i // 2
        mod = (jax.nn.silu(c) @ ada_w[i] + ada_b[i])[:, None, :]
        mod_c = jax.nn.silu(c_ctx) @ ada_w[i] + ada_b[i]
        sh1, sc1, g1, sh2, sc2, g2 = jnp.split(mod, 6, axis=-1)
        csh1, csc1, cg1, csh2, csc2, cg2 = jnp.split(mod_c, 6, axis=-1)
        h = modulate(xl, sh1, sc1)
        hc = modulate(xc, csh1, csc1)
        if i % 2 == 0:
            y = mixer_ab(h, ab_w_in[j], sgu_norm[j], sgu_w[j], sgu_b[j], conv_w[j], ab_w_out[j])
            yc = None if last else mixer_ab(hc, ab_w_in[j], sgu_norm[j], sgu_w[j], sgu_b[j], conv_w[j], ab_w_out[j])
        else:
            y, yc = mixer_cd(h, hc, cd_w_in[j], s5_a_re[j], s5_a_im[j], s5_log_dt[j], s5_b_re[j], s5_b_im[j],
                             s5_c_re[j], s5_c_im[j], s5_d[j], s5_w_glu[j], mla_q_norm[j], mla_kv_norm[j],
                             mla_w_uq[j], mla_w_uk[j], mla_w_uv[j], mla_qn_gain[j], mla_kn_gain[j], cd_w_out[j],
                             angles, not last)
        xl = xl + g1 * y
        xl = xl + g2 * hier_moe(modulate(xl, sh2, sc2), moe_w_grp[i], moe_b_grp[i], moe_w_exp[i], moe_b_exp[i],
                                moe_w_gate[i], moe_w_up[i], moe_w_down[i])
        if not last:
            xc = xc + cg1 * yc
            xc = xc + cg2 * hier_moe(modulate(xc, csh2, csc2), moe_w_grp[i], moe_b_grp[i], moe_w_exp[i],
                                     moe_b_exp[i], moe_w_gate[i], moe_w_up[i], moe_w_down[i])
    return xl
```

```cpp
#include <hip/hip_runtime.h>
#include <stdint.h>
#include <stdio.h>

#define NLAT 16384
#define NCTX 2048
#define NROW 18432
#define LAS __attribute__((address_space(3)))
typedef unsigned short bf16_t;
typedef short bf16x8 __attribute__((ext_vector_type(8)));
typedef float f32x4 __attribute__((ext_vector_type(4)));
typedef float f32x2 __attribute__((ext_vector_type(2)));
typedef float f32x16 __attribute__((ext_vector_type(16)));
typedef unsigned u32x4 __attribute__((ext_vector_type(4)));
typedef unsigned u32x2 __attribute__((ext_vector_type(2)));
#define DI __device__ __forceinline__

DI unsigned cvt_pk_bf16(float lo, float hi) { unsigned r; asm volatile("v_cvt_pk_bf16_f32 %0, %1, %2" : "=v"(r) : "v"(lo), "v"(hi)); return r; }
DI float bf_lo(unsigned w) { return __uint_as_float(w << 16); }
DI float bf_hi(unsigned w) { return __uint_as_float(w & 0xffff0000u); }
DI float bf2f(bf16_t b) { return __uint_as_float(((unsigned)b) << 16); }
DI float fast_exp2(float x) { return __builtin_amdgcn_exp2f(x); }
DI float fast_rcp(float x) { return __builtin_amdgcn_rcpf(x); }
DI float gelu_f(float x) { const float u = x * (0.7978845608f + 0.0356774081f * x * x); return x * fast_rcp(1.f + fast_exp2(-2.885390082f * u)); }
DI float gelu_ns(float x) { float x2; asm volatile("v_mul_f32 %0, %1, %1" : "=v"(x2) : "v"(x)); const float u = x * (0.7978845608f + 0.0356774081f * x2); return x * fast_rcp(1.f + fast_exp2(-2.885390082f * u)); }
DI float silu_f(float x) { return x * fast_rcp(1.f + fast_exp2(-1.442695041f * x)); }
DI float sigm_f(float x) { return fast_rcp(1.f + fast_exp2(-1.442695041f * x)); }
DI int my_tid() { int t = threadIdx.x; asm volatile("" : "+v"(t)); return t; }
DI int modrow(int r) { return r < NLAT ? (r >> 11) : 8; }
DI float wave_sum(float v) {
#pragma unroll
    for (int o = 1; o < 64; o <<= 1) v += __shfl_xor(v, o);
    return v;
}

#define XB_TMO      128
#define XB_XCNT(j)  (256  + 64 * (j))
#define XB_XSUB(j)  (1280 + 64 * (j))
#define XB_XGEN(j)  (2304 + 64 * (j))
#define XB_TOP      3328
#define XB_TOPGEN   3392
#define XCD_BAR_WORDS 3456
#define XB_SPIN_CAP (1u << 18)
DI unsigned xb_ld(unsigned* p)              { return __hip_atomic_load(p, __ATOMIC_RELAXED, __HIP_MEMORY_SCOPE_AGENT); }
DI unsigned xb_add(unsigned* p, unsigned v) { return __hip_atomic_fetch_add(p, v, __ATOMIC_RELAXED, __HIP_MEMORY_SCOPE_AGENT); }
DI unsigned xb_xcc_id() { return (unsigned)__builtin_amdgcn_s_getreg((3 << 11) | 20) & 0xFu; }
#define XB_SPIN(cond, bar) do { unsigned _sp = 0; while (cond) { __builtin_amdgcn_s_sleep(1); \
    if ((++_sp & 255u) == 0u) { if (xb_ld(&(bar)[XB_TMO])) break; if (_sp > XB_SPIN_CAP) { atomicAdd(&(bar)[XB_TMO], 1u); break; } } } } while (0)
struct XcdBarrier { unsigned* bar; unsigned x; volatile LAS unsigned* st; };
DI XcdBarrier xcd_barrier_post(unsigned* bar, volatile LAS unsigned* st) {
    XcdBarrier b; b.bar = bar; b.x = xb_xcc_id(); b.st = st;
    if (threadIdx.x == 0) (void)xb_add(&bar[XB_XCNT(b.x)], 1u);
    return b;
}
DI void xcd_barrier_complete(unsigned* bar, unsigned x, unsigned& nloc, unsigned& nx) {
    const unsigned G = gridDim.x * gridDim.y * gridDim.z;
    unsigned sum, cnt, mine, sp = 0u;
    for (;;) {
        sum = 0u; cnt = 0u; mine = 0u;
#pragma unroll
        for (unsigned j = 0; j < 16; ++j) { const unsigned c = xb_ld(&bar[XB_XCNT(j)]); sum += c; cnt += (c > 0u) ? 1u : 0u; mine = (j == x) ? c : mine; }
        if (sum == G) break;
        __builtin_amdgcn_s_sleep(1);
        if ((++sp & 255u) == 0u) { if (xb_ld(&bar[XB_TMO])) break; if (sp > XB_SPIN_CAP) { atomicAdd(&bar[XB_TMO], 1u); break; } }
    }
    nloc = mine > 0u ? mine : 1u; nx = cnt > 0u ? cnt : 1u;
}
DI void xcd_barrier(const XcdBarrier& b) {
    asm volatile("s_waitcnt vmcnt(0)" ::: "memory");
    __syncthreads();
    if (threadIdx.x == 0) {
        unsigned* bar = b.bar;
        __builtin_amdgcn_s_waitcnt(0);
        unsigned nloc = b.st[0], nx = b.st[1];
        if (nloc == 0u) { xcd_barrier_complete(bar, b.x, nloc, nx); b.st[0] = nloc; b.st[1] = nx; }
        const unsigned old = xb_add(&bar[XB_XSUB(b.x)], 1u);
        const unsigned gen = old / nloc;
        if (old + 1u == (gen + 1u) * nloc) {
            __builtin_amdgcn_fence(__ATOMIC_RELEASE, "agent");
            asm volatile("s_waitcnt vmcnt(0)" ::: "memory");
            const unsigned og = xb_add(&bar[XB_TOP], 1u);
            const unsigned tg = og / nx;
            if (og + 1u == (tg + 1u) * nx) xb_add(&bar[XB_TOPGEN], 1u);
            else XB_SPIN(xb_ld(&bar[XB_TOPGEN]) == tg, bar);
            __builtin_amdgcn_fence(__ATOMIC_ACQUIRE, "agent");
            xb_add(&bar[XB_XGEN(b.x)], 1u);
            asm volatile("s_waitcnt vmcnt(0)" ::: "memory");
        } else {
            XB_SPIN(xb_ld(&bar[XB_XGEN(b.x)]) == gen, bar);
            __builtin_amdgcn_fence(__ATOMIC_ACQUIRE, "agent");
            asm volatile("s_waitcnt vmcnt(0)" ::: "memory");
        }
    }
    __syncthreads();
}

namespace g8 {
constexpr int BM = 256, BK = 64, HALF = 128, HTB = HALF * BK * 2, STAGE_BYTES = 8 * HTB;
__host__ __device__ __forceinline__ int lds_byte(int r, int c) { const int st = (r >> 4) * 2 + (c >> 5), rr = r & 15, cc = c & 31, ob = rr * 64 + cc * 2; return st * 1024 + (ob ^ (((ob >> 9) & 1) << 5)); }
__host__ __device__ __forceinline__ void stage_rc(int b, int& R, int& C) { const int st = b / 1024, sb = b % 1024, swz = sb ^ (((sb >> 9) & 1) << 5); R = (st >> 1) * 16 + swz / 64; C = (st & 1) * 32 + (swz % 64) / 2; }
__host__ __device__ __forceinline__ int perm32(int rho) { const int n = rho >> 4, i = rho & 15; return 8 * (i >> 2) + 4 * n + (i & 3); }

struct Unit { int ty, pm, pn, e, aux; };
struct Addr { const char* A; const char* B; unsigned vA[2][2]; unsigned vB[2]; unsigned hsB; unsigned ksA, ksB; int nt; };
typedef f32x4 Acc[2][2][4][2];

template <class P, class E>
__device__ __forceinline__ void gemm_phase(LAS unsigned char* lds, const P& prob, const E& epi) {
    const int tid = my_tid(), wid = __builtin_amdgcn_readfirstlane(tid >> 6), lane = tid & 63, wr = wid >> 2, wc = wid & 3, fr = lane & 15, fq = lane >> 4;
    int R[2], C[2], Rb[2];
#pragma unroll
    for (int i = 0; i < 2; ++i) { stage_rc(tid * 16 + i * 8192, R[i], C[i]); Rb[i] = E::PERM ? ((R[i] & ~31) + perm32(R[i] & 31)) : R[i]; }
    const unsigned ldsw = (unsigned)wid * 1024u;
    const int aoff = lds_byte(wr * 64 + fr, fq * 8), boff = lds_byte(wc * 32 + fr, fq * 8);
#define G8_SA(b, h) (((b) * 2 + (h)) * HTB)
#define G8_SB(b, h) ((4 + (b) * 2 + (h)) * HTB)
#define G8_STAGE(bufoff, gbase, voff) do { _Pragma("unroll") for (int _i = 0; _i < 2; ++_i) \
        __builtin_amdgcn_global_load_lds((const unsigned*)((const char*)(gbase) + (voff)[_i]), (LAS unsigned*)(lds + (bufoff) + ldsw + _i * 8192), 16, 0, 0); } while (0)
#define G8_LDA(dst, b, h) do { _Pragma("unroll") for (int m = 0; m < 4; ++m) _Pragma("unroll") for (int k = 0; k < 2; ++k) dst[m][k] = *(const LAS bf16x8*)(lds + G8_SA(b, h) + aoff + m * 2048 + k * 1024); } while (0)
#define G8_LDB(dst, b, h) do { _Pragma("unroll") for (int n = 0; n < 2; ++n) _Pragma("unroll") for (int k = 0; k < 2; ++k) dst[n][k] = *(const LAS bf16x8*)(lds + G8_SB(b, h) + boff + n * 2048 + k * 1024); } while (0)
#define G8_MMA(ai, bj, At, Bt) do { __builtin_amdgcn_s_setprio(1); _Pragma("unroll") for (int m = 0; m < 4; ++m) _Pragma("unroll") for (int n = 0; n < 2; ++n) _Pragma("unroll") for (int k = 0; k < 2; ++k) \
        acc[ai][bj][m][n] = __builtin_amdgcn_mfma_f32_16x16x32_bf16(Bt[n][k], At[m][k], acc[ai][bj][m][n], 0, 0, 0); __builtin_amdgcn_s_setprio(0); } while (0)
#define G8_WAIT_V(n) asm volatile("s_waitcnt vmcnt(" #n ")" ::: "memory")
#define G8_WAIT_L(n) asm volatile("s_waitcnt lgkmcnt(" #n ")" ::: "memory")
#define G8_BAR __builtin_amdgcn_s_barrier()
#define G8_SCHED __builtin_amdgcn_sched_barrier(0)
    Unit cur, nxt; int ui = 0;
    if (!prob.next(0, cur)) return;
    Addr ca;
    prob.addr(cur, R, C, Rb, ca);
    f32x4 acc[2][2][4][2];
#pragma unroll
    for (int a = 0; a < 2; ++a)
#pragma unroll
        for (int b = 0; b < 2; ++b)
#pragma unroll
            for (int m = 0; m < 4; ++m)
#pragma unroll
                for (int n = 0; n < 2; ++n) acc[a][b][m][n] = (f32x4){0.f, 0.f, 0.f, 0.f};
    bf16x8 At[4][2], B0[2][2], B1[2][2];
    G8_STAGE(G8_SB(0, 0), ca.B, ca.vB); G8_STAGE(G8_SA(0, 0), ca.A, ca.vA[0]); G8_STAGE(G8_SB(0, 1), ca.B + ca.hsB, ca.vB); G8_STAGE(G8_SA(0, 1), ca.A, ca.vA[1]);
    if (wr == 1) G8_BAR;
    G8_WAIT_V(4); G8_BAR;
    G8_STAGE(G8_SB(1, 0), ca.B + ca.ksB, ca.vB); G8_STAGE(G8_SA(1, 0), ca.A + ca.ksA, ca.vA[0]); G8_STAGE(G8_SB(1, 1), ca.B + ca.hsB + ca.ksB, ca.vB);
    G8_WAIT_V(6); G8_BAR;
    const char* nA = ca.A; const char* nB = ca.B; unsigned nhsB = ca.hsB, nksA = ca.ksA, nksB = ca.ksB; int nnt = ca.nt;
    for (;;) {
        const bool has_next = prob.next(ui + 1, nxt);
        const int nt = ca.nt;
        for (int t = 0; t < nt; t += 2) {
            const bool last = (t == nt - 2);
            const char* a1 = ca.A + (size_t)(t + 1) * ca.ksA;
            G8_LDB(B0, 0, 0); G8_SCHED; G8_LDA(At, 0, 0); G8_STAGE(G8_SA(1, 1), a1, ca.vA[1]);
            if (last) {
                if (has_next) { Addr tn; prob.addr(nxt, R, C, Rb, tn); nA = tn.A; nB = tn.B; nhsB = tn.hsB; nksA = tn.ksA; nksB = tn.ksB; nnt = tn.nt;
#pragma unroll
                    for (int i = 0; i < 2; ++i) { ca.vA[0][i] = tn.vA[0][i]; ca.vA[1][i] = tn.vA[1][i]; ca.vB[i] = tn.vB[i]; } }
                else { nA = ca.A; nB = ca.B; nhsB = ca.hsB; nksA = ca.ksA; nksB = ca.ksB; nnt = ca.nt; }
            }
            const char* a2 = last ? nA : ca.A + (size_t)(t + 2) * ca.ksA; const char* b2 = last ? nB : ca.B + (size_t)(t + 2) * ca.ksB;
            const char* a3 = a2 + (last ? nksA : ca.ksA); const char* b3 = b2 + (last ? nksB : ca.ksB);
            const unsigned hb = last ? nhsB : ca.hsB;
            G8_WAIT_L(8); G8_BAR; G8_WAIT_L(0); G8_MMA(0, 0, At, B0); G8_BAR; G8_SCHED;
            G8_LDB(B1, 0, 1); G8_STAGE(G8_SB(0, 0), b2, ca.vB);
            G8_BAR; G8_WAIT_L(0); G8_MMA(0, 1, At, B1); G8_BAR;
            G8_LDA(At, 0, 1); G8_STAGE(G8_SA(0, 0), a2, ca.vA[0]);
            G8_BAR; G8_WAIT_L(0); G8_MMA(1, 0, At, B0); G8_BAR; G8_SCHED;
            G8_STAGE(G8_SB(0, 1), b2 + hb, ca.vB);
            G8_WAIT_V(6); G8_BAR; G8_MMA(1, 1, At, B1); G8_BAR;
            G8_LDB(B0, 1, 0); G8_SCHED; G8_LDA(At, 1, 0); G8_STAGE(G8_SA(0, 1), a2, ca.vA[1]);
            G8_WAIT_L(8); G8_BAR; G8_WAIT_L(0); G8_MMA(0, 0, At, B0); G8_BAR; G8_SCHED;
            G8_LDB(B1, 1, 1); G8_STAGE(G8_SB(1, 0), b3, ca.vB);
            G8_BAR; G8_WAIT_L(0); G8_MMA(0, 1, At, B1); G8_BAR;
            G8_LDA(At, 1, 1); G8_STAGE(G8_SA(1, 0), a3, ca.vA[0]);
            G8_BAR; G8_WAIT_L(0); G8_MMA(1, 0, At, B0); G8_BAR; G8_SCHED;
            G8_STAGE(G8_SB(1, 1), b3 + hb, ca.vB);
            G8_WAIT_V(6); G8_BAR; G8_MMA(1, 1, At, B1); G8_BAR;
        }
        epi(acc, cur, wr, wc, fr, fq);
        if (!has_next) break;
#pragma unroll
        for (int a = 0; a < 2; ++a)
#pragma unroll
            for (int b = 0; b < 2; ++b)
#pragma unroll
                for (int m = 0; m < 4; ++m)
#pragma unroll
                    for (int n = 0; n < 2; ++n) acc[a][b][m][n] = (f32x4){0.f, 0.f, 0.f, 0.f};
        cur = nxt; ca.A = nA; ca.B = nB; ca.hsB = nhsB; ca.ksA = nksA; ca.ksB = nksB; ca.nt = nnt; ++ui;
    }
    G8_WAIT_V(0);
    if (wr == 0) G8_BAR;
    G8_BAR;
#undef G8_SA
#undef G8_SB
#undef G8_STAGE
#undef G8_LDA
#undef G8_LDB
#undef G8_MMA
#undef G8_WAIT_V
#undef G8_WAIT_L
#undef G8_BAR
#undef G8_SCHED
}

DI void addr_plain(Addr& a, const void* Abase, unsigned sA, const void* Bbase, unsigned sB, int nt, const int (&R)[2], const int (&C)[2], const int (&Rb)[2]) {
    a.A = (const char*)Abase; a.B = (const char*)Bbase; a.ksA = 128u; a.ksB = 128u; a.nt = nt; a.hsB = 128u * sB;
#pragma unroll
    for (int i = 0; i < 2; ++i) { a.vA[0][i] = (unsigned)R[i] * sA + (unsigned)C[i] * 2u; a.vA[1][i] = a.vA[0][i] + 128u * sA; a.vB[i] = (unsigned)Rb[i] * sB + (unsigned)C[i] * 2u; }
}
template <int ACT> DI void store8(bf16_t* p, const f32x4& v0, const f32x4& v1) {
    float x[8] = {v0[0], v0[1], v0[2], v0[3], v1[0], v1[1], v1[2], v1[3]};
    if (ACT == 1) {
#pragma unroll
        for (int j = 0; j < 8; ++j) x[j] = gelu_f(x[j]);
    }
    u32x4 w; w.x = cvt_pk_bf16(x[0], x[1]); w.y = cvt_pk_bf16(x[2], x[3]); w.z = cvt_pk_bf16(x[4], x[5]); w.w = cvt_pk_bf16(x[6], x[7]);
    *(u32x4*)p = w;
}
}
struct Params { const float* in[37]; float* out; unsigned char* ws; };
enum { I_X = 0, I_C, I_CTX, I_CCTX, I_ADAW, I_ADAB, I_ABWIN, I_SGUNORM, I_SGUW, I_SGUB, I_CONVW, I_ABWOUT, I_CDWIN, I_S5ARE, I_S5AIM, I_S5LOGDT, I_S5BRE, I_S5BIM, I_S5CRE, I_S5CIM,
       I_S5D, I_S5WGLU, I_QNORM, I_KVNORM, I_WUQ, I_WUK, I_WUV, I_QNGAIN, I_KNGAIN, I_CDWOUT, I_WGRP, I_BGRP, I_WEXP, I_BEXP, I_WGATE, I_WUP, I_WDOWN };
constexpr size_t AL(size_t x) { return (x + 255) & ~(size_t)255; }
constexpr size_t CTL_BAR = 0;
constexpr size_t CTL_CNT = 16384;
constexpr size_t CTL_VSS = 32768;
constexpr size_t CTL_SS1 = CTL_VSS + NROW * 4;
constexpr size_t CTL_SS2 = CTL_SS1 + NROW * 4;
constexpr size_t CTL_SSQ = CTL_SS2 + NROW * 4;
constexpr size_t CTL_SSKV = CTL_SSQ + NROW * 4;
constexpr size_t CTL_HSS = CTL_SSKV + NROW * 4;
constexpr size_t CTL_BYTES = AL(CTL_HSS + (size_t)NLAT * 8 * 4);
constexpr size_t WS_MOD = CTL_BYTES;
constexpr size_t WS_ROPE = AL(WS_MOD + 2 * 9 * 6144 * 4);
constexpr size_t WS_WRT = AL(WS_ROPE + 2 * 64 * 8 * 4);
constexpr size_t WS_S5A16 = AL(WS_WRT + (size_t)2 * 36 * 1024 * 4);
constexpr size_t WS_WABIN = AL(WS_S5A16 + (size_t)2 * 32 * 64 * 2 * 4);
constexpr size_t WS_WABOUT = AL(WS_WABIN + (size_t)5120 * 1024 * 2);
constexpr size_t WS_WCDIN = AL(WS_WABOUT + (size_t)1024 * 2048 * 2);
constexpr size_t WS_WGLU = AL(WS_WCDIN + (size_t)1792 * 1024 * 2);
constexpr size_t WS_WUQ = AL(WS_WGLU + (size_t)512 * 512 * 2);
constexpr size_t WS_WUK = AL(WS_WUQ + (size_t)768 * 768 * 2);
constexpr size_t WS_WUV = AL(WS_WUK + (size_t)512 * 256 * 2);
constexpr size_t WS_WCDOUT = AL(WS_WUV + (size_t)512 * 256 * 2);
constexpr size_t WS_S5WEND = AL(WS_WCDOUT + (size_t)1024 * 1024 * 2);
constexpr size_t WS_S5WY = AL(WS_S5WEND + (size_t)32 * 256 * 256 * 2);
constexpr size_t WS_W1 = AL(WS_S5WY + (size_t)32 * 256 * 512 * 2);
constexpr size_t WS_W2 = AL(WS_W1 + (size_t)32 * 1024 * 1024 * 2);
constexpr size_t WS_XC = AL(WS_W2 + (size_t)32 * 1024 * 512 * 2);
constexpr size_t WS_HB = AL(WS_XC + (size_t)NCTX * 1024 * 4);
constexpr size_t WS_ROUTE = AL(WS_HB + (size_t)NROW * 1024 * 2);
constexpr size_t WS_RWT = AL(WS_ROUTE + (size_t)NROW * 16);
constexpr size_t WS_LIST = AL(WS_RWT + (size_t)NROW * 8);
constexpr size_t WS_SCR = AL(WS_LIST + (size_t)32 * NROW * 4);
constexpr size_t WS_ZU = WS_SCR;
constexpr size_t WS_GVT = AL(WS_ZU + (size_t)NROW * 1024 * 2);
constexpr size_t WS_ZB = AL(WS_GVT + (size_t)NROW * 1024 * 2);
constexpr size_t WS_MIX = AL(WS_ZB + (size_t)NROW * 3072 * 2);
constexpr size_t WS_L0END = AL(WS_MIX + (size_t)NROW * 2048 * 2);
constexpr int MOE_ROWS = 2 * NROW + 32 * 256;
constexpr size_t WS_HID = WS_SCR;
constexpr size_t WS_YS = AL(WS_HID + (size_t)MOE_ROWS * 512 * 2);
constexpr size_t WS_MOEEND = AL(WS_YS + (size_t)MOE_ROWS * 1024 * 2);
constexpr size_t WS_ZZ = WS_SCR;
constexpr size_t WS_UC = AL(WS_ZZ + (size_t)NROW * 1280 * 2);
constexpr size_t WS_SEND = AL(WS_UC + (size_t)32 * 1280 * 512 * 2);
constexpr size_t WS_Q = AL(WS_SEND + (size_t)32 * 1280 * 256 * 4);
constexpr size_t WS_K = AL(WS_Q + (size_t)NLAT * 768 * 2);
constexpr size_t WS_VT = AL(WS_K + (size_t)NROW * 768 * 2);
constexpr size_t WS_G = AL(WS_VT + (size_t)512 * NROW * 2);
constexpr size_t WS_MIXCD = AL(WS_G + (size_t)NLAT * 512 * 2);
constexpr size_t WS_L1END = AL(WS_MIXCD + (size_t)NLAT * 1024 * 2);
DI void sincos_f64(double x, double& s, double& c) {
    const double twopi = 6.283185307179586476925286766559;
    const double r = x - twopi * rint(x / twopi);
    const double r2 = r * r;
    double ts = 1.0, tc = 1.0;
#pragma unroll
    for (int k = 14; k >= 1; --k) { ts = 1.0 - ts * r2 / (double)((2 * k) * (2 * k + 1)); tc = 1.0 - tc * r2 / (double)((2 * k - 1) * (2 * k)); }
    s = r * ts; c = tc;
}
DI void s5_tables(const Params& p, LAS unsigned char* lds, int g) {
    const int tid = my_tid();
    LAS float* PW = (LAS float*)lds;
    LAS float* BB = PW + 2 * 64 * 17 * 2;
    LAS float* CC = BB + 2 * 64 * 16 * 2;
    LAS float* KL = CC + 2 * 16 * 64 * 2;
    if (tid < 128) {
        const int d = tid >> 6, pp = tid & 63, i = (d * 32 + g) * 64 + pp;
        const double dt = exp((double)p.in[I_S5LOGDT][d * 32 + g]);
        const double ar = (double)p.in[I_S5ARE][i], ai = (double)p.in[I_S5AIM][i];
        const double mag = exp(dt * ar); double sn, cs; sincos_f64(dt * ai, sn, cs);
        const double abr = mag * cs, abi = mag * sn;
        const double den = ar * ar + ai * ai, nr = abr - 1.0;
        const double fr = (nr * ar + abi * ai) / den, fi = (abi * ar - nr * ai) / den;
        double pr = 1.0, pi = 0.0;
        for (int k = 0; k <= 16; ++k) { PW[((d * 64 + pp) * 17 + k) * 2] = (float)pr; PW[((d * 64 + pp) * 17 + k) * 2 + 1] = (float)pi; const double nr2 = pr * abr - pi * abi, ni2 = pr * abi + pi * abr; pr = nr2; pi = ni2; }
        float* a16 = (float*)(p.ws + WS_S5A16) + (size_t)i * 2;
        a16[0] = PW[((d * 64 + pp) * 17 + 16) * 2]; a16[1] = PW[((d * 64 + pp) * 17 + 16) * 2 + 1];
        for (int c = 0; c < 16; ++c) { const double br = (double)p.in[I_S5BRE][(size_t)i * 16 + c], bi = (double)p.in[I_S5BIM][(size_t)i * 16 + c];
            BB[((d * 64 + pp) * 16 + c) * 2] = (float)(fr * br - fi * bi); BB[((d * 64 + pp) * 16 + c) * 2 + 1] = (float)(fr * bi + fi * br); }
    }
    for (int i = tid; i < 2 * 16 * 64; i += 512) { const int d = i >> 10, r = i & 1023;
        const size_t src = (size_t)(d * 32 + g) * 1024 + r; CC[i * 2] = p.in[I_S5CRE][src]; CC[i * 2 + 1] = p.in[I_S5CIM][src]; }
    __syncthreads();
    for (int i = tid; i < 2 * 16 * 256; i += 512) {
        const int d = i >> 12, lag = (i >> 8) & 15, c = (i >> 4) & 15, c2 = i & 15;
        float acc = 0.f;
        for (int pp = 0; pp < 64; ++pp) {
            const float cr = CC[((d * 16 + c) * 64 + pp) * 2], ci = CC[((d * 16 + c) * 64 + pp) * 2 + 1];
            const float ar = PW[((d * 64 + pp) * 17 + lag) * 2], ai = PW[((d * 64 + pp) * 17 + lag) * 2 + 1];
            const float br = BB[((d * 64 + pp) * 16 + c2) * 2], bi = BB[((d * 64 + pp) * 16 + c2) * 2 + 1];
            const float tr = ar * br - ai * bi, ti = ar * bi + ai * br;
            acc += cr * tr - ci * ti;
        }
        KL[i] = acc;
    }
    __syncthreads();
    bf16_t* WY = (bf16_t*)(p.ws + WS_S5WY) + (size_t)g * 256 * 512;
    bf16_t* WE = (bf16_t*)(p.ws + WS_S5WEND) + (size_t)g * 256 * 256;
    const float* dsk = p.in[I_S5D] + g * 16;
    for (int i = tid; i < 256 * 512 / 2; i += 512) {
        const int n = i >> 8, k0 = (i & 255) * 2, s = n >> 4, c = n & 15;
        float v[2];
#pragma unroll
        for (int e = 0; e < 2; ++e) { const int k = k0 + e; float x;
            if (k < 256) { const int s2 = k >> 4, c2 = k & 15; x = 0.f;
                if (s2 <= s) x += KL[((0 * 16 + (s - s2)) * 16 + c) * 16 + c2];
                if (s2 >= s) x += KL[((1 * 16 + (s2 - s)) * 16 + c) * 16 + c2];
                if (s2 == s && c2 == c) x += dsk[c];
            } else { const int j = k - 256, d = j >> 7, pp = (j >> 1) & 63, im = j & 1, pw = d == 0 ? s + 1 : 16 - s;
                const float cr = CC[((d * 16 + c) * 64 + pp) * 2], ci = CC[((d * 16 + c) * 64 + pp) * 2 + 1];
                const float ar = PW[((d * 64 + pp) * 17 + pw) * 2], ai = PW[((d * 64 + pp) * 17 + pw) * 2 + 1];
                const float zr = cr * ar - ci * ai, zi = cr * ai + ci * ar;
                x = im ? -zi : zr; }
            v[e] = x; }
        *(unsigned*)(WY + (size_t)n * 512 + k0) = cvt_pk_bf16(v[0], v[1]);
    }
    for (int i = tid; i < 256 * 256 / 2; i += 512) {
        const int j = i >> 7, k0 = (i & 127) * 2, d = j >> 7, pp = (j >> 1) & 63, im = j & 1;
        float v[2];
#pragma unroll
        for (int e = 0; e < 2; ++e) { const int k = k0 + e, s2 = k >> 4, c2 = k & 15, pw = d == 0 ? 15 - s2 : s2;
            const float ar = PW[((d * 64 + pp) * 17 + pw) * 2], ai = PW[((d * 64 + pp) * 17 + pw) * 2 + 1];
            const float br = BB[((d * 64 + pp) * 16 + c2) * 2], bi = BB[((d * 64 + pp) * 16 + c2) * 2 + 1];
            v[e] = im ? (ar * bi + ai * br) : (ar * br - ai * bi); }
        *(unsigned*)(WE + (size_t)j * 256 + k0) = cvt_pk_bf16(v[0], v[1]);
    }
    __syncthreads();
}
DI int rowmap(int ty, int n) {
    if (ty == 0) return n;
    if (ty == 1) return ((n >> 7) << 8) + (n & 127);
    const int h = n >> 6, d = n & 63; return 256 * (h >> 2) + 128 * (d >> 5) + 32 * (h & 3) + (d & 31);
}
DI void transpose_item(const float* W, int N, int k0, int n0, bf16_t* WT, int dld, int rty, int roff, const float* kscale, LAS float* scr, int lane) {
    f32x4 v[8];
    const int kr = lane >> 3, nq = (lane & 7) * 4;
#pragma unroll
    for (int i = 0; i < 8; ++i) v[i] = *(const f32x4*)(W + (size_t)(k0 + kr + 8 * i) * N + n0 + nq);
#pragma unroll
    for (int i = 0; i < 8; ++i) { LAS float* d = scr + (kr + 8 * i) * 33 + nq; d[0] = v[i][0]; d[1] = v[i][1]; d[2] = v[i][2]; d[3] = v[i][3]; }
    asm volatile("s_waitcnt lgkmcnt(0)" ::: "memory");
    const int c = lane & 7;
    float ks[8];
#pragma unroll
    for (int i = 0; i < 8; ++i) ks[i] = kscale ? kscale[k0 + 8 * c + i] : 1.f;
#pragma unroll
    for (int j = 0; j < 4; ++j) { const int n = (lane >> 3) + 8 * j; const LAS float* s = scr + (8 * c) * 33 + n;
        u32x4 o; o.x = cvt_pk_bf16(s[0 * 33] * ks[0], s[1 * 33] * ks[1]); o.y = cvt_pk_bf16(s[2 * 33] * ks[2], s[3 * 33] * ks[3]);
        o.z = cvt_pk_bf16(s[4 * 33] * ks[4], s[5 * 33] * ks[5]); o.w = cvt_pk_bf16(s[6 * 33] * ks[6], s[7 * 33] * ks[7]);
        *(u32x4*)(WT + (size_t)(roff + rowmap(rty, n0 + n)) * dld + k0 + 8 * c) = o; }
    asm volatile("s_waitcnt lgkmcnt(0)" ::: "memory");
}
DI void transpose_job(int it, const float* W, int K, int N, bf16_t* WT, int rty, int roff, const float* kscale, LAS float* scr, int lane) {
    const int nblk = N >> 5, kb = it / nblk, nb = it - kb * nblk;
    transpose_item(W, N, kb * 64, nb * 32, WT, K, rty, roff, kscale, scr, lane);
}
DI void moe_convert_item(const Params& p, int layer, int it, LAS float* scr, int lane) {
    const int e = it / 768, r = it - e * 768;
    bf16_t* W1 = (bf16_t*)(p.ws + WS_W1) + (size_t)e * 1024 * 1024; bf16_t* W2 = (bf16_t*)(p.ws + WS_W2) + (size_t)e * 1024 * 512;
    const size_t eo = ((size_t)layer * 32 + e) * 1024 * 512;
    if (r < 256) transpose_job(r, p.in[I_WGATE] + eo, 1024, 512, W1, 1, 0, nullptr, scr, lane);
    else if (r < 512) transpose_job(r - 256, p.in[I_WUP] + eo, 1024, 512, W1, 1, 128, nullptr, scr, lane);
    else transpose_job(r - 512, p.in[I_WDOWN] + eo, 512, 1024, W2, 0, 0, nullptr, scr, lane);
}
constexpr int P0_SMALL = 2560 + 1024 + 784 + 128 + 288 + 64 + 64 + 512;
constexpr int P0_MOE = 32 * 768;
DI void p0_small_item(const Params& p, int it, LAS float* scr, int lane) {
    unsigned char* ws = p.ws;
    if (it < 2560) { transpose_job(it, p.in[I_ABWIN], 1024, 5120, (bf16_t*)(ws + WS_WABIN), 0, 0, nullptr, scr, lane); return; } it -= 2560;
    if (it < 1024) { transpose_job(it, p.in[I_ABWOUT], 2048, 1024, (bf16_t*)(ws + WS_WABOUT), 0, 0, nullptr, scr, lane); return; } it -= 1024;
    if (it < 784) { transpose_job(it, p.in[I_CDWIN], 1024, 1568, (bf16_t*)(ws + WS_WCDIN), 0, 0, nullptr, scr, lane); return; } it -= 784;
    if (it < 128) { transpose_job(it, p.in[I_S5WGLU], 512, 512, (bf16_t*)(ws + WS_WGLU), 0, 0, nullptr, scr, lane); return; } it -= 128;
    if (it < 288) { transpose_job(it, p.in[I_WUQ], 768, 768, (bf16_t*)(ws + WS_WUQ), 0, 0, p.in[I_QNORM], scr, lane); return; } it -= 288;
    if (it < 64) { transpose_job(it, p.in[I_WUK], 256, 512, (bf16_t*)(ws + WS_WUK), 2, 0, p.in[I_KVNORM], scr, lane); return; } it -= 64;
    if (it < 64) { transpose_job(it, p.in[I_WUV], 256, 512, (bf16_t*)(ws + WS_WUV), 0, 0, p.in[I_KVNORM], scr, lane); return; } it -= 64;
    transpose_job(it, p.in[I_CDWOUT], 1024, 1024, (bf16_t*)(ws + WS_WCDOUT), 0, 0, nullptr, scr, lane);
}
DI void sincos_red(float a, float& s, float& c) {
    const float k = rintf(a * 0.15915494309189535f);
    float r = fmaf(-k, 6.2831854820251465f, a);
    r = fmaf(-k, -1.7484555e-7f, r);
    s = __sinf(r); c = __cosf(r);
}
DI void phase_p0(const Params& p, LAS unsigned char* lds) {
    const int tid = my_tid(), lane = tid & 63, wave = __builtin_amdgcn_readfirstlane(tid >> 6), G = gridDim.x;
    LAS float* sc = (LAS float*)(lds + 8 * 16384 - 9 * 4096);
    if (blockIdx.x < 192) {
        for (int i = tid; i < 9 * 1024; i += 512) { const int r = i >> 10, k = i & 1023; const float v = r < 8 ? p.in[I_C][r * 1024 + k] : p.in[I_CCTX][k]; sc[i] = v / (1.f + expf(-v)); }
    }
    __syncthreads();
    if (blockIdx.x >= 200 && blockIdx.x < 232) s5_tables(p, lds, blockIdx.x - 200);
    if (blockIdx.x < 192) {
        const int layer = blockIdx.x / 96, n = (blockIdx.x % 96) * 64 + lane;
        const float* w = p.in[I_ADAW] + (size_t)layer * 1024 * 6144 + (size_t)(wave * 128) * 6144 + n;
        float acc[9];
#pragma unroll
        for (int r = 0; r < 9; ++r) acc[r] = 0.f;
#pragma unroll 1
        for (int k0 = 0; k0 < 128; k0 += 16) { float wv[16];
#pragma unroll
            for (int k = 0; k < 16; ++k) wv[k] = w[(size_t)(k0 + k) * 6144];
#pragma unroll
            for (int k = 0; k < 16; ++k)
#pragma unroll
                for (int r = 0; r < 9; ++r) acc[r] += sc[r * 1024 + wave * 128 + k0 + k] * wv[k]; }
        LAS float* red = (LAS float*)(lds + 69632);
#pragma unroll
        for (int r = 0; r < 9; ++r) red[(wave * 9 + r) * 64 + lane] = acc[r];
        __syncthreads();
        float* mod = (float*)(p.ws + WS_MOD);
        for (int i = tid; i < 9 * 64; i += 512) { const int r = i >> 6, c = i & 63; float sum = 0.f;
#pragma unroll
            for (int wv2 = 0; wv2 < 8; ++wv2) sum += red[(wv2 * 9 + r) * 64 + c];
            const int nn = (blockIdx.x % 96) * 64 + c;
            mod[((size_t)layer * 9 + r) * 6144 + nn] = sum + p.in[I_ADAB][layer * 6144 + nn]; }
        __syncthreads();
    }
    if (!(blockIdx.x >= 200 && blockIdx.x < 232)) {
        const int vb = blockIdx.x < 200 ? blockIdx.x : blockIdx.x - 32, NVW = (G - 32) * 8;
        LAS float* scr = (LAS float*)(lds + wave * 8704);
        for (int it = vb * 8 + wave; it < P0_SMALL + P0_MOE; it += NVW) { if (it < P0_SMALL) p0_small_item(p, it, scr, lane); else moe_convert_item(p, 0, it - P0_SMALL, scr, lane); }
    }
    {
        u32x4* z = (u32x4*)((bf16_t*)(p.ws + WS_WCDIN) + (size_t)1568 * 1024);
        const int n16 = 224 * 1024 * 2 / 16;
        for (int i = blockIdx.x * 512 + tid; i < n16; i += G * 512) z[i] = (u32x4){0u, 0u, 0u, 0u};
    }
    {
        float* wrt = (float*)(p.ws + WS_WRT);
        for (int i = blockIdx.x * 512 + tid; i < 2 * 36 * 1024; i += G * 512) { const int layer = i / 36864, r = i - layer * 36864, o = r >> 10, k = r & 1023;
            wrt[i] = o < 4 ? p.in[I_WGRP][(size_t)layer * 4096 + k * 4 + o] : p.in[I_WEXP][(size_t)layer * 32768 + k * 32 + (o - 4)]; }
    }
    if (blockIdx.x == G - 1) {
        float* rope = (float*)(p.ws + WS_ROPE);
        const int pos = tid >> 3, i = tid & 7;
        const float inv = powf(10000.f, -(float)i / 8.f);
        float s, c; sincos_red((float)pos * inv, s, c);
        rope[tid] = c; rope[512 + tid] = s;
    }
}

DI const float* resid_row_l0(const Params& p, int row) { return row < NLAT ? p.in[I_X] + (size_t)row * 1024 : p.in[I_CTX] + (size_t)(row - NLAT) * 1024; }
DI void modulate_store(const f32x4 (&v)[4], float rinv, const float* mod, int sh_off, int sc_off, bf16_t* orow, int lane) {
#pragma unroll
    for (int j = 0; j < 4; ++j) { const int c = (lane + 64 * j) * 4;
        const f32x4 sh = *(const f32x4*)(mod + sh_off + c), sc = *(const f32x4*)(mod + sc_off + c);
        const f32x4 o = v[j] * rinv * (sc + 1.f) + sh;
        u32x2 w; w.x = cvt_pk_bf16(o[0], o[1]); w.y = cvt_pk_bf16(o[2], o[3]);
        *(u32x2*)(orow + c) = w; }
}
DI void phase_p1(const Params& p) {
    const int tid_ = my_tid(); const int lane = tid_ & 63, wave = __builtin_amdgcn_readfirstlane(tid_ >> 6);
    const float* mod0 = (const float*)(p.ws + WS_MOD);
    bf16_t* Hb = (bf16_t*)(p.ws + WS_HB);
    const int NW = gridDim.x * 8;
    for (int row0 = blockIdx.x * 8 + wave; row0 < NROW; row0 += 3 * NW) {
        f32x4 v[3][4]; float ss[3];
#pragma unroll
        for (int u = 0; u < 3; ++u) { const int row = row0 + u * NW; ss[u] = 0.f;
            if (row < NROW) { const f32x4* xr = (const f32x4*)resid_row_l0(p, row) + lane;
#pragma unroll
                for (int j = 0; j < 4; ++j) v[u][j] = xr[64 * j]; } }
#pragma unroll
        for (int u = 0; u < 3; ++u) { const int row = row0 + u * NW;
            if (row < NROW) {
#pragma unroll
                for (int j = 0; j < 4; ++j) ss[u] += v[u][j][0] * v[u][j][0] + v[u][j][1] * v[u][j][1] + v[u][j][2] * v[u][j][2] + v[u][j][3] * v[u][j][3];
                const float rinv = rsqrtf(wave_sum(ss[u]) * (1.f / 1024.f) + 1e-6f);
                modulate_store(v[u], rinv, mod0 + (size_t)modrow(row) * 6144, 0, 1024, Hb + (size_t)row * 1024, lane); } }
    }
}

struct ProbABin {
    const bf16_t* Hb; const bf16_t* Wt; int G, c;
    DI bool next(int i, g8::Unit& u) const {
        const int L = i * G + c; if (L >= 72 * 20) return false;
        const int panel = L / 20, j = L - panel * 20;
        if (j < 4) { u.ty = 0; u.pm = panel; u.pn = j; } else if (j < 16) { u.ty = 1; u.pm = panel; u.pn = j - 4; } else { u.ty = 2; u.pm = j - 16; u.pn = panel; }
        u.e = 0; u.aux = 0; return true;
    }
    DI void addr(const g8::Unit& u, const int (&R)[2], const int (&C)[2], const int (&Rb)[2], g8::Addr& a) const {
        const bf16_t *A, *B;
        if (u.ty == 0) { A = Hb + (size_t)u.pm * 256 * 1024; B = Wt + (size_t)u.pn * 256 * 1024; }
        else if (u.ty == 1) { A = Hb + (size_t)u.pm * 256 * 1024; B = Wt + (size_t)(2048 + u.pn * 256) * 1024; }
        else { A = Wt + (size_t)(1024 + u.pm * 256) * 1024; B = Hb + (size_t)u.pn * 256 * 1024; }
        g8::addr_plain(a, A, 2048u, B, 2048u, 16, R, C, Rb);
    }
};
struct EpiABin {
    static constexpr bool PERM = true;
    bf16_t* Zu; bf16_t* ZB; bf16_t* GVt; float* VSS; int dry;
    DI void operator()(g8::Acc& acc, const g8::Unit& u, int wr, int wc, int fr, int fq) const {
        asm volatile("" : "+v"(fr), "+v"(fq));
        const int row0 = u.pm * 256 + wr * 64 + fr, col0 = u.pn * 256 + wc * 32 + 8 * fq;
        bf16_t* const base = u.ty == 0 ? Zu : (u.ty == 1 ? ZB : GVt);
        const size_t ld = u.ty == 0 ? 1024 : (u.ty == 1 ? 3072 : NROW);
        const bool raw = (u.ty == 1);
        float ss[2][8];
#pragma unroll
        for (int bj = 0; bj < 2; ++bj)
#pragma unroll
            for (int j = 0; j < 8; ++j) ss[bj][j] = 0.f;
#pragma unroll
        for (int ai = 0; ai < 2; ++ai)
#pragma unroll
            for (int m = 0; m < 4; ++m)
#pragma unroll
                for (int bj = 0; bj < 2; ++bj) {
                    float x[8];
#pragma unroll
                    for (int j = 0; j < 4; ++j) { x[j] = acc[ai][bj][m][0][j]; x[4 + j] = acc[ai][bj][m][1][j]; }
#pragma unroll
                    for (int j = 0; j < 8; ++j) { const float g = gelu_f(x[j]); x[j] = raw ? x[j] : g; ss[bj][j] += x[j] * x[j]; }
                    u32x4 w; w.x = cvt_pk_bf16(x[0], x[1]); w.y = cvt_pk_bf16(x[2], x[3]); w.z = cvt_pk_bf16(x[4], x[5]); w.w = cvt_pk_bf16(x[6], x[7]);
                    *(u32x4*)(base + (size_t)(row0 + ai * 128 + m * 16) * ld + col0 + bj * 128) = w;
                    __builtin_amdgcn_sched_barrier(0);
                }
        if (u.ty == 2 && !dry) {
#pragma unroll
            for (int bj = 0; bj < 2; ++bj)
#pragma unroll
                for (int j = 0; j < 8; ++j) { float s = ss[bj][j]; s += __shfl_xor(s, 1); s += __shfl_xor(s, 2); s += __shfl_xor(s, 4); s += __shfl_xor(s, 8);
                    if (fr == 0) atomicAdd(VSS + col0 + bj * 128 + j, s); }
        }
    }
};
DI void phase_p2(const Params& p, LAS unsigned char* lds, int dry = 0) {
    ProbABin P{(const bf16_t*)(p.ws + WS_HB), (const bf16_t*)(p.ws + WS_WABIN), (int)gridDim.x, (int)blockIdx.x};
    EpiABin E{(bf16_t*)(p.ws + WS_ZU), (bf16_t*)(p.ws + WS_ZB), (bf16_t*)(p.ws + WS_GVT), (float*)(p.ws + CTL_VSS), dry};
    g8::gemm_phase(lds, P, E);
}
DI void phase_p3(const Params& p, LAS unsigned char* lds) {
    const int tid = my_tid(), lane = tid & 63, wave = __builtin_amdgcn_readfirstlane(tid >> 6), fr = lane & 15, fq = lane >> 4;
    const bf16_t* Zu = (const bf16_t*)(p.ws + WS_ZU); const bf16_t* GVt = (const bf16_t*)(p.ws + WS_GVT); const bf16_t* ZB = (const bf16_t*)(p.ws + WS_ZB);
    const float* VSS = (const float*)(p.ws + CTL_VSS); bf16_t* MIX = (bf16_t*)(p.ws + WS_MIX);
    const float* sgu_norm = p.in[I_SGUNORM]; const float* sgu_w = p.in[I_SGUW]; const float* sgu_b = p.in[I_SGUB]; const float* conv_w = p.in[I_CONVW];
    for (int task = blockIdx.x * 512 + tid; task < 1024 * 128; task += gridDim.x * 512) {
        const int tb = task >> 7, ch = (task & 127) * 8, t0 = tb * 18;
        float w0[8], w1[8], w2[8];
#pragma unroll
        for (int j = 0; j < 2; ++j) { const f32x4 a = *(const f32x4*)(conv_w + ch + 4 * j), b = *(const f32x4*)(conv_w + 1024 + ch + 4 * j), c = *(const f32x4*)(conv_w + 2048 + ch + 4 * j);
#pragma unroll
            for (int e = 0; e < 4; ++e) { w0[4 * j + e] = a[e]; w1[4 * j + e] = b[e]; w2[4 * j + e] = c[e]; } }
        float prev[8], cur[8];
        {   const bf16_t* z = ZB + (size_t)t0 * 3072 + ch;
            const u32x4 c1 = *(const u32x4*)(z + 1024), x1 = *(const u32x4*)(z + 2048);
            u32x4 c0 = (u32x4){0u, 0u, 0u, 0u}, x0 = c0;
            if (t0 > 0) { c0 = *(const u32x4*)(z - 3072 + 1024); x0 = *(const u32x4*)(z - 3072 + 2048); }
#pragma unroll
            for (int j = 0; j < 4; ++j) { prev[2 * j] = bf_lo(c0[j]) * bf_lo(x0[j]); prev[2 * j + 1] = bf_hi(c0[j]) * bf_hi(x0[j]); cur[2 * j] = bf_lo(c1[j]) * bf_lo(x1[j]); cur[2 * j + 1] = bf_hi(c1[j]) * bf_hi(x1[j]); } }
#pragma unroll 1
        for (int s0 = 0; s0 < 18; s0 += 6) {
            u32x4 gb[6], cn[6], xn[6];
#pragma unroll
            for (int k = 0; k < 6; ++k) { const int t = t0 + s0 + k; const bf16_t* z = ZB + (size_t)t * 3072 + ch; gb[k] = *(const u32x4*)z;
                const bool hn = t + 1 < NROW; cn[k] = hn ? *(const u32x4*)(z + 3072 + 1024) : (u32x4){0u, 0u, 0u, 0u}; xn[k] = hn ? *(const u32x4*)(z + 3072 + 2048) : (u32x4){0u, 0u, 0u, 0u}; }
#pragma unroll
            for (int k = 0; k < 6; ++k) { const int t = t0 + s0 + k;
                const int l = t < NLAT ? (t & 2047) : ((t - NLAT) & 255), len = t < NLAT ? 2048 : 256;
                const float mp = l > 0 ? 1.f : 0.f, mn = l < len - 1 ? 1.f : 0.f;
                float nx[8]; unsigned o[4];
#pragma unroll
                for (int j = 0; j < 4; ++j) { nx[2 * j] = bf_lo(cn[k][j]) * bf_lo(xn[k][j]); nx[2 * j + 1] = bf_hi(cn[k][j]) * bf_hi(xn[k][j]); }
#pragma unroll
                for (int j = 0; j < 4; ++j) {
                    const float lo = bf_lo(gb[k][j]) * (w0[2 * j] * prev[2 * j] * mp + w1[2 * j] * cur[2 * j] + w2[2 * j] * nx[2 * j] * mn);
                    const float hi = bf_hi(gb[k][j]) * (w0[2 * j + 1] * prev[2 * j + 1] * mp + w1[2 * j + 1] * cur[2 * j + 1] + w2[2 * j + 1] * nx[2 * j + 1] * mn);
                    o[j] = cvt_pk_bf16(lo, hi); }
                *(u32x4*)(MIX + (size_t)t * 2048 + 1024 + ch) = (u32x4){o[0], o[1], o[2], o[3]};
#pragma unroll
                for (int j = 0; j < 8; ++j) { prev[j] = cur[j]; cur[j] = nx[j]; }
            }
        }
    }
    LAS unsigned char* Wl = lds; LAS unsigned char* Vl = lds + 34816;
    const int g = blockIdx.x & 7, ch0 = g * 128;
    const int pp_w = tid >> 2, part = tid & 3;
    f32x4 wreg[8];
    {   const f32x4* src = (const f32x4*)(sgu_w + ((size_t)g * 128 + pp_w) * 128 + part * 32);
#pragma unroll
        for (int i = 0; i < 8; ++i) wreg[i] = src[i]; }
    const int nit = (144 * 8 - (int)blockIdx.x + (int)gridDim.x - 1) / (int)gridDim.x;
    u32x4 vreg[4]; f32x4 rvr[8];
    auto prefetch = [&](int it) { const int c = (it * (int)gridDim.x + (int)blockIdx.x) >> 3, t0 = c * 128;
        const u32x4* src = (const u32x4*)(GVt + (size_t)(ch0 + pp_w) * NROW + t0 + part * 32);
#pragma unroll
        for (int i = 0; i < 4; ++i) vreg[i] = src[i];
#pragma unroll
        for (int i = 0; i < 8; ++i) rvr[i] = *(const f32x4*)(VSS + t0 + part * 32 + 4 * i); };
    if (nit > 0) prefetch(0);
    for (int it = 0; it < nit; ++it) {
        const int c = (it * (int)gridDim.x + (int)blockIdx.x) >> 3, t0 = c * 128;
        __syncthreads();
#pragma unroll
        for (int i = 0; i < 4; ++i) *(LAS u32x4*)(Vl + pp_w * 272 + part * 64 + i * 16) = vreg[i];
#pragma unroll
        for (int i = 0; i < 4; ++i) { const f32x4 a = wreg[2 * i], b = wreg[2 * i + 1]; f32x4 r0 = rvr[2 * i], r1 = rvr[2 * i + 1];
#pragma unroll
            for (int e = 0; e < 4; ++e) { r0[e] = rsqrtf(r0[e] * (1.f / 1024.f) + 1e-6f); r1[e] = rsqrtf(r1[e] * (1.f / 1024.f) + 1e-6f); }
            u32x4 w; w.x = cvt_pk_bf16(a[0] * r0[0], a[1] * r0[1]); w.y = cvt_pk_bf16(a[2] * r0[2], a[3] * r0[3]); w.z = cvt_pk_bf16(b[0] * r1[0], b[1] * r1[1]); w.w = cvt_pk_bf16(b[2] * r1[2], b[3] * r1[3]);
            *(LAS u32x4*)(Wl + pp_w * 272 + part * 64 + i * 16) = w; }
        __syncthreads();
        if (it + 1 < nit) prefetch(it + 1);
        const int pp = wave * 16 + fr, tok = t0 + pp;
        u32x2 gu[8];
#pragma unroll
        for (int n = 0; n < 8; ++n) gu[n] = *(const u32x2*)(Zu + (size_t)tok * 1024 + ch0 + n * 16 + 4 * fq);
        f32x4 acc[8];
#pragma unroll
        for (int n = 0; n < 8; ++n) acc[n] = (f32x4){0.f, 0.f, 0.f, 0.f};
#pragma unroll
        for (int ks = 0; ks < 4; ++ks) {
            const bf16x8 wf = *(const LAS bf16x8*)(Wl + (wave * 16 + fr) * 272 + ks * 64 + fq * 16);
#pragma unroll
            for (int n = 0; n < 8; ++n) { const bf16x8 vf = *(const LAS bf16x8*)(Vl + (n * 16 + fr) * 272 + ks * 64 + fq * 16);
                acc[n] = __builtin_amdgcn_mfma_f32_16x16x32_bf16(vf, wf, acc[n], 0, 0, 0); }
        }
        const float bb = sgu_b[g * 128 + pp];
#pragma unroll
        for (int n = 0; n < 8; ++n) { const int ch = ch0 + n * 16 + 4 * fq;
            const f32x4 nm = *(const f32x4*)(sgu_norm + ch);
            const float y0 = bf_lo(gu[n].x) * (acc[n][0] * nm[0] + bb), y1 = bf_hi(gu[n].x) * (acc[n][1] * nm[1] + bb), y2 = bf_lo(gu[n].y) * (acc[n][2] * nm[2] + bb), y3 = bf_hi(gu[n].y) * (acc[n][3] * nm[3] + bb);
            u32x2 w; w.x = cvt_pk_bf16(y0, y1); w.y = cvt_pk_bf16(y2, y3);
            *(u32x2*)(MIX + (size_t)tok * 2048 + ch) = w; }
    }
}

struct ProbPlain {
    const void* A; const void* B; unsigned sA, sB; int nM, nN, nt, G, c;
    DI bool next(int i, g8::Unit& u) const { const int L = i * G + c; if (L >= nM * nN) return false; u.ty = 0; u.pm = L / nN; u.pn = L - u.pm * nN; u.e = 0; u.aux = 0; return true; }
    DI void addr(const g8::Unit& u, const int (&R)[2], const int (&C)[2], const int (&Rb)[2], g8::Addr& a) const {
        g8::addr_plain(a, (const char*)A + (size_t)u.pm * 256 * sA, sA, (const char*)B + (size_t)u.pn * 256 * sB, sB, nt, R, C, Rb);
    }
};
struct EpiResid {
    static constexpr bool PERM = false;
    const float* xin_lat; const float* xin_ctx; float* xout_lat; float* xout_ctx; const float* gate; float* SS; int dry;
    DI void operator()(g8::Acc& acc, const g8::Unit& u, int wr, int wc, int fr, int fq) const {
        asm volatile("" : "+v"(fr), "+v"(fq));
        const int rowt = u.pm * 256; const bool lat = rowt < NLAT;
        const float* xin = lat ? xin_lat + (size_t)rowt * 1024 : xin_ctx + (size_t)(rowt - NLAT) * 1024;
        float* xout = lat ? xout_lat + (size_t)rowt * 1024 : xout_ctx + (size_t)(rowt - NLAT) * 1024;
        const float* gt = gate + (size_t)modrow(rowt) * 6144;
        const int col0 = u.pn * 256 + wc * 32 + 4 * fq;
        f32x4 gv[2][2];
#pragma unroll
        for (int bj = 0; bj < 2; ++bj)
#pragma unroll
            for (int n = 0; n < 2; ++n) gv[bj][n] = *(const f32x4*)(gt + col0 + bj * 128 + n * 16);
#pragma unroll
        for (int ai = 0; ai < 2; ++ai)
#pragma unroll
            for (int m = 0; m < 4; ++m) {
                const int rl = ai * 128 + wr * 64 + m * 16 + fr; const size_t ro = (size_t)rl * 1024 + col0;
                float ss = 0.f;
#pragma unroll
                for (int bj = 0; bj < 2; ++bj)
#pragma unroll
                    for (int n = 0; n < 2; ++n) { const f32x4 xi = *(const f32x4*)(xin + ro + bj * 128 + n * 16); const f32x4 o = xi + gv[bj][n] * acc[ai][bj][m][n];
                        *(f32x4*)(xout + ro + bj * 128 + n * 16) = o; ss += o[0] * o[0] + o[1] * o[1] + o[2] * o[2] + o[3] * o[3]; }
                ss += __shfl_xor(ss, 16); ss += __shfl_xor(ss, 32);
                if (fq == 0 && !dry) atomicAdd(SS + rowt + rl, ss);
                __builtin_amdgcn_sched_barrier(0);
            }
    }
};
DI void phase_p4(const Params& p, LAS unsigned char* lds, int dry = 0) {
    ProbPlain P{p.ws + WS_MIX, p.ws + WS_WABOUT, 4096u, 4096u, 72, 4, 32, (int)gridDim.x, (int)blockIdx.x};
    EpiResid E{p.in[I_X], p.in[I_CTX], p.out, (float*)(p.ws + WS_XC), (const float*)(p.ws + WS_MOD) + 2048, (float*)(p.ws + CTL_SS1), dry};
    g8::gemm_phase(lds, P, E);
}
constexpr int LDS_MISC = 147456;
DI float* resid_row(const Params& p, int row) { return row < NLAT ? p.out + (size_t)row * 1024 : (float*)(p.ws + WS_XC) + (size_t)(row - NLAT) * 1024; }

template <int LAYER> DI void phase_router(const Params& p, LAS unsigned char* lds, int dry = 0) {
    constexpr int NR = LAYER == 0 ? NROW : NLAT;
    const int tid = my_tid(), lane = tid & 63, wave = __builtin_amdgcn_readfirstlane(tid >> 6);
    LAS float* W = (LAS float*)lds;
    {   const f32x4* src = (const f32x4*)((const float*)(p.ws + WS_WRT) + (size_t)LAYER * 36 * 1024);
        for (int i = tid; i < 36 * 256; i += 512) *(LAS f32x4*)(W + i * 4) = src[i]; }
    __syncthreads();
    const float* mod = (const float*)(p.ws + WS_MOD) + (size_t)LAYER * 9 * 6144;
    const float* SS = (const float*)(p.ws + (LAYER == 0 ? CTL_SS1 : CTL_SS2));
    const float* bg = p.in[I_BGRP] + LAYER * 4; const float* be = p.in[I_BEXP] + LAYER * 32;
    unsigned* cnt = (unsigned*)(p.ws + CTL_CNT) + LAYER * 32 * 64;
    int* ROUTE = (int*)(p.ws + (dry ? WS_MOEEND : WS_ROUTE)); float* RWT = (float*)(p.ws + (dry ? WS_MOEEND + (8u << 20) : WS_RWT)); int* LIST = (int*)(p.ws + (dry ? WS_MOEEND + (16u << 20) : WS_LIST));
    bf16_t* Hb = (bf16_t*)(p.ws + WS_HB);
    if (dry) cnt = (unsigned*)(p.ws + WS_MOEEND + (32u << 20));
    const int half = lane >> 5, ex = lane & 31;
    for (int row0 = (blockIdx.x * 8 + wave) * 2; row0 < NR; row0 += gridDim.x * 16) {
        f32x4 t[2][4];
#pragma unroll
        for (int rr = 0; rr < 2; ++rr) { const int row = row0 + rr;
            const f32x4* xr = (const f32x4*)resid_row(p, row) + lane;
            const float* m = mod + (size_t)modrow(row) * 6144;
            const float rinv = rsqrtf(SS[row] * (1.f / 1024.f) + 1e-6f);
#pragma unroll
            for (int j = 0; j < 4; ++j) { const int c = (lane + 64 * j) * 4; const f32x4 sh = *(const f32x4*)(m + 3072 + c), sc = *(const f32x4*)(m + 4096 + c);
                t[rr][j] = xr[64 * j] * rinv * (sc + 1.f) + sh;
                u32x2 w; w.x = cvt_pk_bf16(t[rr][j][0], t[rr][j][1]); w.y = cvt_pk_bf16(t[rr][j][2], t[rr][j][3]);
                *(u32x2*)(Hb + (size_t)row * 1024 + c) = w; } }
        float gq[4], v[64];
#pragma unroll
        for (int o = 0; o < 36; ++o) { float a0 = 0.f, a1 = 0.f;
#pragma unroll
            for (int j = 0; j < 4; ++j) { const f32x4 w = *(const LAS f32x4*)(W + o * 1024 + (lane + 64 * j) * 4);
                a0 += t[0][j][0] * w[0] + t[0][j][1] * w[1] + t[0][j][2] * w[2] + t[0][j][3] * w[3]; a1 += t[1][j][0] * w[0] + t[1][j][1] * w[1] + t[1][j][2] * w[2] + t[1][j][3] * w[3]; }
            if (o < 4) { const float send = half ? a0 : a1, keep = half ? a1 : a0; gq[o] = keep + __shfl_xor(send, 32); }
            else { v[o - 4] = a0; v[32 + o - 4] = a1; }
            if ((o & 7) == 7) __builtin_amdgcn_sched_barrier(0);
        }
#pragma unroll
        for (int o = 0; o < 4; ++o) { float g = gq[o]; g += __shfl_xor(g, 16); g += __shfl_xor(g, 8); g += __shfl_xor(g, 4); g += __shfl_xor(g, 2); g += __shfl_xor(g, 1); gq[o] = g; }
#define RT_STAGE(n, msk) { const bool up = (lane & (msk)) != 0; _Pragma("unroll") for (int i = 0; i < (n) / 2; ++i) { const float lo_ = v[i], hi_ = v[i + (n) / 2]; v[i] = (up ? hi_ : lo_) + __shfl_xor(up ? lo_ : hi_, (msk)); } }
        RT_STAGE(64, 32) RT_STAGE(32, 16) RT_STAGE(16, 8) RT_STAGE(8, 4) RT_STAGE(4, 2) RT_STAGE(2, 1)
#undef RT_STAGE
        const int row = row0 + half;
        int grp = 0; float mx = gq[0] + bg[0];
        float gl[4];
#pragma unroll
        for (int i = 0; i < 4; ++i) gl[i] = gq[i] + bg[i];
#pragma unroll
        for (int i = 1; i < 4; ++i) if (gl[i] > mx) { mx = gl[i]; grp = i; }
        float den = 0.f;
#pragma unroll
        for (int i = 0; i < 4; ++i) den += expf(gl[i] - mx);
        const float ptop = 1.f / den;
        const float el = v[0] + be[ex]; const bool valid = (ex >> 3) == grp;
        float m1 = valid ? el : -3.0e38f;
#pragma unroll
        for (int o = 1; o < 32; o <<= 1) m1 = fmaxf(m1, __shfl_xor(m1, o));
        const unsigned long long b1 = __ballot(valid && el == m1);
        const int i0 = __builtin_ctz((unsigned)(b1 >> (32 * half)));
        float m2 = (valid && ex != i0) ? el : -3.0e38f;
#pragma unroll
        for (int o = 1; o < 32; o <<= 1) m2 = fmaxf(m2, __shfl_xor(m2, o));
        const unsigned long long b2 = __ballot(valid && ex != i0 && el == m2);
        const int i1 = __builtin_ctz((unsigned)(b2 >> (32 * half)));
        const float exx = expf(m2 - m1);
        const float w0 = ptop / (1.f + exx), w1 = ptop * exx / (1.f + exx);
        if (ex == 0) {
            const int ea = i0, eb = i1;
            const int pa = (int)__hip_atomic_fetch_add(cnt + ea * 64, 1u, __ATOMIC_RELAXED, __HIP_MEMORY_SCOPE_AGENT);
            const int pb = (int)__hip_atomic_fetch_add(cnt + eb * 64, 1u, __ATOMIC_RELAXED, __HIP_MEMORY_SCOPE_AGENT);
            *(int4*)(ROUTE + (size_t)row * 4) = make_int4(ea, pa, eb, pb);
            *(float2*)(RWT + (size_t)row * 2) = make_float2(w0, w1);
            LIST[(size_t)ea * NROW + (dry ? 0 : pa)] = row; LIST[(size_t)eb * NROW + (dry ? 1 : pb)] = row;
        }
    }
}
DI void moe_tables(const Params& p, int layer, LAS unsigned char* lds) {
    LAS int* tb = (LAS int*)(lds + LDS_MISC + 64);
    const unsigned* cnt = (const unsigned*)(p.ws + CTL_CNT) + layer * 32 * 64;
    if (threadIdx.x < 32) tb[threadIdx.x] = (int)cnt[threadIdx.x * 64];
    __syncthreads();
    if (threadIdx.x == 0) { int a = 0; for (int e = 0; e < 32; ++e) { tb[32 + e] = a; a += (tb[e] + 255) >> 8; } tb[64] = a; }
    __syncthreads();
}
struct ProbMoe {
    const bf16_t* A; const bf16_t* W; const int* LIST; LAS const int* tb; int gather; unsigned sA, sB; int nt, G, c; size_t wstride;
    DI bool next(int i, g8::Unit& u) const {
        const int L = i * G + c; if (L >= tb[64] * 4) return false;
        const int tile = L >> 2; int e = 0;
        for (int k = 1; k < 32; ++k) e = (tb[32 + k] <= tile) ? k : e;
        u.ty = 0; u.e = e; u.pm = tile - tb[32 + e]; u.pn = L & 3; u.aux = tb[32 + e] * 256; return true;
    }
    DI void addr(const g8::Unit& u, const int (&R)[2], const int (&C)[2], const int (&Rb)[2], g8::Addr& a) const {
        const char* Bb = (const char*)(W + (size_t)u.e * wstride) + (size_t)u.pn * 256 * sB;
        if (gather) {
            g8::addr_plain(a, A, sA, Bb, sB, nt, R, C, Rb);
            const int n = tb[u.e]; const int* lst = LIST + (size_t)u.e * NROW;
#pragma unroll
            for (int h = 0; h < 2; ++h)
#pragma unroll
                for (int i = 0; i < 2; ++i) { const int pos = u.pm * 256 + h * 128 + R[i]; const int tok = lst[pos < n ? pos : 0]; a.vA[h][i] = (unsigned)tok * sA + (unsigned)C[i] * 2u; }
        } else {
            g8::addr_plain(a, (const char*)A + (size_t)(u.aux + u.pm * 256) * sA, sA, Bb, sB, nt, R, C, Rb);
        }
    }
};
struct EpiMoe1 {
    static constexpr bool PERM = true;
    bf16_t* Hid;
    DI void operator()(g8::Acc& acc, const g8::Unit& u, int wr, int wc, int fr, int fq) const {
        asm volatile("" : "+v"(fr), "+v"(fq));
        const int row0 = u.aux + u.pm * 256 + wr * 64 + fr, col0 = u.pn * 128 + wc * 32 + 8 * fq;
#pragma unroll
        for (int ai = 0; ai < 2; ++ai)
#pragma unroll
            for (int m = 0; m < 4; ++m) {
                float x[8];
#pragma unroll
                for (int j = 0; j < 4; ++j) { x[j] = silu_f(acc[ai][0][m][0][j]) * acc[ai][1][m][0][j]; x[4 + j] = silu_f(acc[ai][0][m][1][j]) * acc[ai][1][m][1][j]; }
                u32x4 w; w.x = cvt_pk_bf16(x[0], x[1]); w.y = cvt_pk_bf16(x[2], x[3]); w.z = cvt_pk_bf16(x[4], x[5]); w.w = cvt_pk_bf16(x[6], x[7]);
                *(u32x4*)(Hid + (size_t)(row0 + ai * 128 + m * 16) * 512 + col0) = w;
                __builtin_amdgcn_sched_barrier(0);
            }
    }
};
struct EpiMoe2 {
    static constexpr bool PERM = true;
    bf16_t* Ys;
    DI void operator()(g8::Acc& acc, const g8::Unit& u, int wr, int wc, int fr, int fq) const {
        asm volatile("" : "+v"(fr), "+v"(fq));
        const int row0 = u.aux + u.pm * 256 + wr * 64 + fr, col0 = u.pn * 256 + wc * 32 + 8 * fq;
#pragma unroll
        for (int ai = 0; ai < 2; ++ai)
#pragma unroll
            for (int m = 0; m < 4; ++m)
#pragma unroll
                for (int bj = 0; bj < 2; ++bj) g8::store8<0>(Ys + (size_t)(row0 + ai * 128 + m * 16) * 1024 + col0 + bj * 128, acc[ai][bj][m][0], acc[ai][bj][m][1]);
    }
};
template <int LAYER> DI void phase_moe1(const Params& p, LAS unsigned char* lds) {
    moe_tables(p, LAYER, lds);
    ProbMoe P{(const bf16_t*)(p.ws + WS_HB), (const bf16_t*)(p.ws + WS_W1), (const int*)(p.ws + WS_LIST), (LAS const int*)(lds + LDS_MISC + 64), 1, 2048u, 2048u, 16, (int)gridDim.x, (int)blockIdx.x, (size_t)1024 * 1024};
    EpiMoe1 E{(bf16_t*)(p.ws + WS_HID)};
    g8::gemm_phase(lds, P, E);
}
template <int LAYER> DI void phase_moe2(const Params& p, LAS unsigned char* lds) {
    moe_tables(p, LAYER, lds);
    ProbMoe P{(const bf16_t*)(p.ws + WS_HID), (const bf16_t*)(p.ws + WS_W2), nullptr, (LAS const int*)(lds + LDS_MISC + 64), 0, 1024u, 1024u, 8, (int)gridDim.x, (int)blockIdx.x, (size_t)1024 * 512};
    EpiMoe2 E{(bf16_t*)(p.ws + WS_YS)};
    g8::gemm_phase(lds, P, E);
}
template <int LAYER> DI void phase_combine(const Params& p, LAS unsigned char* lds, int dry = 0) {
    constexpr int NR = LAYER == 0 ? NROW : NLAT;
    moe_tables(p, LAYER, lds);
    LAS const int* tb = (LAS const int*)(lds + LDS_MISC + 64);
    const int tid_ = my_tid(); const int lane = tid_ & 63, wave = __builtin_amdgcn_readfirstlane(tid_ >> 6);
    const float* mod = (const float*)(p.ws + WS_MOD) + (size_t)LAYER * 9 * 6144;
    const int* ROUTE = (const int*)(p.ws + WS_ROUTE); const float* RWT = (const float*)(p.ws + WS_RWT);
    const bf16_t* Ys = (const bf16_t*)(p.ws + WS_YS); bf16_t* Hb = (bf16_t*)(p.ws + WS_HB);
    const int NW = gridDim.x * 8;
    for (int row0 = blockIdx.x * 8 + wave; row0 < NR; row0 += 2 * NW) {
        int4 rt[2]; float2 wt[2];
#pragma unroll
        for (int u = 0; u < 2; ++u) { const int row = row0 + u * NW < NR ? row0 + u * NW : row0; rt[u] = *(const int4*)(ROUTE + (size_t)row * 4); wt[u] = *(const float2*)(RWT + (size_t)row * 2); }
        u32x2 ya[2][4], yb[2][4]; f32x4 xv[2][4];
#pragma unroll
        for (int u = 0; u < 2; ++u) { const int row = row0 + u * NW < NR ? row0 + u * NW : row0;
            const bf16_t* y0 = Ys + (size_t)(tb[32 + rt[u].x] * 256 + rt[u].y) * 1024; const bf16_t* y1 = Ys + (size_t)(tb[32 + rt[u].z] * 256 + rt[u].w) * 1024;
            const float* xr = resid_row(p, row);
#pragma unroll
            for (int j = 0; j < 4; ++j) { const int c = (lane + 64 * j) * 4; ya[u][j] = *(const u32x2*)(y0 + c); yb[u][j] = *(const u32x2*)(y1 + c); xv[u][j] = *(const f32x4*)(xr + c); } }
#pragma unroll
        for (int u = 0; u < 2; ++u) { const int row = row0 + u * NW;
            if (row < NR) {
                float* xr = resid_row(p, row);
                float* xw = dry ? (float*)(p.ws + WS_MOEEND) + (size_t)(row & 8191) * 1024 : xr;
                const float* m = mod + (size_t)modrow(row) * 6144;
                f32x4 v[4]; float ss = 0.f;
#pragma unroll
                for (int j = 0; j < 4; ++j) { const int c = (lane + 64 * j) * 4;
                    const u32x2 a = ya[u][j], b2 = yb[u][j]; const f32x4 g = *(const f32x4*)(m + 5120 + c);
                    f32x4 y; y[0] = wt[u].x * bf_lo(a.x) + wt[u].y * bf_lo(b2.x); y[1] = wt[u].x * bf_hi(a.x) + wt[u].y * bf_hi(b2.x); y[2] = wt[u].x * bf_lo(a.y) + wt[u].y * bf_lo(b2.y); y[3] = wt[u].x * bf_hi(a.y) + wt[u].y * bf_hi(b2.y);
                    v[j] = xv[u][j] + g * y;
                    *(f32x4*)(xw + c) = v[j];
                    ss += v[j][0] * v[j][0] + v[j][1] * v[j][1] + v[j][2] * v[j][2] + v[j][3] * v[j][3]; }
                if (LAYER == 0) {
                    const float rinv = rsqrtf(wave_sum(ss) * (1.f / 1024.f) + 1e-6f);
                    modulate_store(v, rinv, m + 9 * 6144, 0, 1024, (dry ? (bf16_t*)(p.ws + WS_MOEEND + (64u << 20)) + (size_t)(row & 8191) * 1024 : Hb + (size_t)row * 1024), lane);
                }
            }
        }
    }
    if (LAYER == 0) {
        __syncthreads();
        LAS float* scr = (LAS float*)(lds + wave * 8704);
        for (int it = blockIdx.x * 8 + wave; it < P0_MOE; it += gridDim.x * 8) moe_convert_item(p, 1, it, scr, lane);
    }
}
typedef __bf16 bf16v2 __attribute__((ext_vector_type(2)));
DI unsigned pk_bf16(float lo, float hi) { f32x2 v = {lo, hi}; bf16v2 b = __builtin_convertvector(v, bf16v2); return __builtin_bit_cast(unsigned, b); }

struct ProbCDin {
    const bf16_t* Hb; const bf16_t* Wt; int G, c;
    DI bool next(int i, g8::Unit& u) const {
        const int L = i * G + c; if (L >= 448 + 32) return false;
        if (L < 448) { u.pm = L / 7; u.pn = L - u.pm * 7; } else { const int r = L - 448; u.pm = 64 + (r >> 2); const int q = r & 3; u.pn = q < 2 ? q : q + 3; }
        u.ty = 0; u.e = 0; u.aux = 0; return true;
    }
    DI void addr(const g8::Unit& u, const int (&R)[2], const int (&C)[2], const int (&Rb)[2], g8::Addr& a) const {
        g8::addr_plain(a, Hb + (size_t)u.pm * 256 * 1024, 2048u, Wt + (size_t)u.pn * 256 * 1024, 2048u, 16, R, C, Rb);
    }
};
struct EpiCDin {
    static constexpr bool PERM = true;
    bf16_t* UC; bf16_t* ZZ; float* SSQ; float* SSKV; int dry;
    DI void operator()(g8::Acc& acc, const g8::Unit& u, int wr, int wc, int fr, int fq) const {
        asm volatile("" : "+v"(fr), "+v"(fq));
        const int row0 = u.pm * 256 + wr * 64 + fr, colw = u.pn * 256 + wc * 32 + 8 * fq;
        const bool isu = u.pn < 2;
        float* const SS = u.pn == 5 ? SSKV : SSQ; const bool stat = (u.pn >= 2 && u.pn <= 5);
#pragma unroll
        for (int ai = 0; ai < 2; ++ai)
#pragma unroll
            for (int m = 0; m < 4; ++m) {
                const int row = row0 + ai * 128 + m * 16; float ss = 0.f;
#pragma unroll
                for (int bj = 0; bj < 2; ++bj) { const int col = colw + bj * 128;
                    bf16_t* du = UC + ((size_t)(col >> 4) * 1280 + (row >> 4)) * 512 + (row & 15) * 16 + (col & 15);
                    bf16_t* dz = ZZ + (size_t)row * 1280 + (col - 512);
                    g8::store8<0>(isu ? du : dz, acc[ai][bj][m][0], acc[ai][bj][m][1]);
#pragma unroll
                    for (int j = 0; j < 4; ++j) ss += acc[ai][bj][m][0][j] * acc[ai][bj][m][0][j] + acc[ai][bj][m][1][j] * acc[ai][bj][m][1][j]; }
                ss += __shfl_xor(ss, 16); ss += __shfl_xor(ss, 32);
                if (stat && fq == 0 && !dry) atomicAdd(SS + row, ss);
                __builtin_amdgcn_sched_barrier(0);
            }
    }
};
DI void phase_cdin(const Params& p, LAS unsigned char* lds, int dry = 0) {
    ProbCDin P{(const bf16_t*)(p.ws + WS_HB), (const bf16_t*)(p.ws + WS_WCDIN), (int)gridDim.x, (int)blockIdx.x};
    EpiCDin E{(bf16_t*)(p.ws + WS_UC), (bf16_t*)(p.ws + WS_ZZ), (float*)(p.ws + CTL_SSQ), (float*)(p.ws + CTL_SSKV), dry};
    g8::gemm_phase(lds, P, E);
}

struct ProbS5 {
    const bf16_t* UC; const bf16_t* W; int nPm, nt; unsigned sB; size_t wstride; int G, c;
    DI bool next(int i, g8::Unit& u) const { const int L = i * G + c; if (L >= 32 * nPm) return false; u.e = L / nPm; u.pm = L - u.e * nPm; u.pn = 0; u.ty = 0; u.aux = 0; return true; }
    DI void addr(const g8::Unit& u, const int (&R)[2], const int (&C)[2], const int (&Rb)[2], g8::Addr& a) const {
        g8::addr_plain(a, UC + ((size_t)u.e * 1280 + u.pm * 256) * 512, 1024u, W + (size_t)u.e * wstride, sB, nt, R, C, Rb);
    }
};
struct EpiSend {
    static constexpr bool PERM = false;
    float* S;
    DI void operator()(g8::Acc& acc, const g8::Unit& u, int wr, int wc, int fr, int fq) const {
        asm volatile("" : "+v"(fr), "+v"(fq));
        float* base = S + ((size_t)u.e * 1280 + u.pm * 256 + wr * 64 + fr) * 256 + wc * 32 + 4 * fq;
#pragma unroll
        for (int ai = 0; ai < 2; ++ai)
#pragma unroll
            for (int m = 0; m < 4; ++m)
#pragma unroll
                for (int bj = 0; bj < 2; ++bj)
#pragma unroll
                    for (int n = 0; n < 2; ++n) *(f32x4*)(base + (size_t)(ai * 128 + m * 16) * 256 + bj * 128 + n * 16) = acc[ai][bj][m][n];
    }
};
struct EpiQ {
    static constexpr bool PERM = true;
    bf16_t* Q; const float* SSQ; float* HSS; const float* gain; const float* rope; int dry;
    DI void operator()(g8::Acc& acc, const g8::Unit& u, int wr, int wc, int fr, int fq) const {
        asm volatile("" : "+v"(fr), "+v"(fq));
        const int row0 = u.pm * 256 + wr * 64 + fr;
        float gn[2][8]; int head[2]; bool rp[2];
#pragma unroll
        for (int bj = 0; bj < 2; ++bj) { const int grp = u.pn * 8 + bj * 4 + wc; head[bj] = grp / 3; const int part = grp - head[bj] * 3; rp[bj] = (part == 2);
#pragma unroll
            for (int j = 0; j < 8; ++j) gn[bj][j] = gain[part * 32 + 8 * fq + j]; }
        const float sgn = (fq & 1) ? 1.f : -1.f;
#pragma unroll
        for (int ai = 0; ai < 2; ++ai)
#pragma unroll
            for (int m = 0; m < 4; ++m) {
                const int row = row0 + ai * 128 + m * 16, l = row & 2047, pos = fq < 2 ? (l >> 6) : (l & 63);
                const float rq = rsqrtf(SSQ[row] * (1.f / 768.f) + 1e-6f);
                const f32x4 c0 = *(const f32x4*)(rope + pos * 8), c1 = *(const f32x4*)(rope + pos * 8 + 4), s0 = *(const f32x4*)(rope + 512 + pos * 8), s1 = *(const f32x4*)(rope + 512 + pos * 8 + 4);
                const float cs[8] = {c0[0], c0[1], c0[2], c0[3], c1[0], c1[1], c1[2], c1[3]}, sn[8] = {s0[0], s0[1], s0[2], s0[3], s1[0], s1[1], s1[2], s1[3]};
#pragma unroll
                for (int bj = 0; bj < 2; ++bj) {
                    float x[8], ss = 0.f;
#pragma unroll
                    for (int j = 0; j < 4; ++j) { x[j] = acc[ai][bj][m][0][j] * rq; x[4 + j] = acc[ai][bj][m][1][j] * rq; }
#pragma unroll
                    for (int j = 0; j < 8; ++j) { ss += x[j] * x[j]; x[j] *= gn[bj][j]; }
                    ss += __shfl_xor(ss, 16); ss += __shfl_xor(ss, 32);
                    if (fq == 0 && !dry) atomicAdd(HSS + (size_t)row * 8 + head[bj], ss);
#pragma unroll
                    for (int j = 0; j < 8; ++j) { const float pr = __shfl_xor(x[j], 16); const float cc = rp[bj] ? cs[j] : 1.f, sv = rp[bj] ? sgn * sn[j] : 0.f; x[j] = x[j] * cc + pr * sv; }
                    u32x4 w; w.x = cvt_pk_bf16(x[0], x[1]); w.y = cvt_pk_bf16(x[2], x[3]); w.z = cvt_pk_bf16(x[4], x[5]); w.w = cvt_pk_bf16(x[6], x[7]);
                    *(u32x4*)(Q + (size_t)row * 768 + u.pn * 256 + bj * 128 + wc * 32 + 8 * fq) = w;
                }
                __builtin_amdgcn_sched_barrier(0);
            }
    }
};
struct EpiK {
    static constexpr bool PERM = true;
    bf16_t* K; const bf16_t* ZZ; const float* SSKV; const float* gain; const float* rope;
    DI void operator()(g8::Acc& acc, const g8::Unit& u, int wr, int wc, int fr, int fq) const {
        asm volatile("" : "+v"(fr), "+v"(fq));
        const int row0 = u.pm * 256 + wr * 64 + fr, head = u.pn * 4 + wc;
        float gn[2][8], gr[8], gp[8];
#pragma unroll
        for (int j = 0; j < 8; ++j) { gn[0][j] = gain[8 * fq + j]; gn[1][j] = gain[32 + 8 * fq + j]; gr[j] = gain[64 + 8 * fq + j]; gp[j] = gain[64 + 8 * (fq ^ 1) + j]; }
        const float sgn = (fq & 1) ? 1.f : -1.f;
#pragma unroll
        for (int ai = 0; ai < 2; ++ai)
#pragma unroll
            for (int m = 0; m < 4; ++m) {
                const int row = row0 + ai * 128 + m * 16; const bool lat = row < NLAT; const int l = row & 2047, pos = fq < 2 ? (l >> 6) : (l & 63);
                const float rkv = rsqrtf(SSKV[row] * (1.f / 256.f) + 1e-6f);
                const u32x4 ko = *(const u32x4*)(ZZ + (size_t)row * 1280 + 1024 + 8 * fq), kp = *(const u32x4*)(ZZ + (size_t)row * 1280 + 1024 + 8 * (fq ^ 1));
                float xo[8] = {bf_lo(ko.x), bf_hi(ko.x), bf_lo(ko.y), bf_hi(ko.y), bf_lo(ko.z), bf_hi(ko.z), bf_lo(ko.w), bf_hi(ko.w)};
                const float xp[8] = {bf_lo(kp.x), bf_hi(kp.x), bf_lo(kp.y), bf_hi(kp.y), bf_lo(kp.z), bf_hi(kp.z), bf_lo(kp.w), bf_hi(kp.w)};
                float ss = 0.f;
#pragma unroll
                for (int j = 0; j < 8; ++j) ss += xo[j] * xo[j];
                float xn[2][8];
#pragma unroll
                for (int bj = 0; bj < 2; ++bj)
#pragma unroll
                    for (int j = 0; j < 4; ++j) { xn[bj][j] = acc[ai][bj][m][0][j] * rkv; xn[bj][4 + j] = acc[ai][bj][m][1][j] * rkv; }
#pragma unroll
                for (int bj = 0; bj < 2; ++bj)
#pragma unroll
                    for (int j = 0; j < 8; ++j) ss += xn[bj][j] * xn[bj][j];
                ss += __shfl_xor(ss, 16); ss += __shfl_xor(ss, 32);
                const float rk = rsqrtf(ss * (1.f / 96.f) + 1e-6f);
                const f32x4 c0 = *(const f32x4*)(rope + pos * 8), c1 = *(const f32x4*)(rope + pos * 8 + 4), s0 = *(const f32x4*)(rope + 512 + pos * 8), s1 = *(const f32x4*)(rope + 512 + pos * 8 + 4);
                const float cs[8] = {c0[0], c0[1], c0[2], c0[3], c1[0], c1[1], c1[2], c1[3]}, sn[8] = {s0[0], s0[1], s0[2], s0[3], s1[0], s1[1], s1[2], s1[3]};
                bf16_t* kr = K + (size_t)row * 768 + head * 96;
#pragma unroll
                for (int bj = 0; bj < 2; ++bj) { u32x4 w;
                    w.x = cvt_pk_bf16(xn[bj][0] * gn[bj][0] * rk, xn[bj][1] * gn[bj][1] * rk); w.y = cvt_pk_bf16(xn[bj][2] * gn[bj][2] * rk, xn[bj][3] * gn[bj][3] * rk);
                    w.z = cvt_pk_bf16(xn[bj][4] * gn[bj][4] * rk, xn[bj][5] * gn[bj][5] * rk); w.w = cvt_pk_bf16(xn[bj][6] * gn[bj][6] * rk, xn[bj][7] * gn[bj][7] * rk);
                    *(u32x4*)(kr + bj * 32 + 8 * fq) = w; }
#pragma unroll
                for (int j = 0; j < 8; ++j) { const float cc = lat ? cs[j] : 1.f, sv = lat ? sgn * sn[j] : 0.f; xo[j] = (xo[j] * gr[j] * cc + xp[j] * gp[j] * sv) * rk; }
                u32x4 w; w.x = cvt_pk_bf16(xo[0], xo[1]); w.y = cvt_pk_bf16(xo[2], xo[3]); w.z = cvt_pk_bf16(xo[4], xo[5]); w.w = cvt_pk_bf16(xo[6], xo[7]);
                *(u32x4*)(kr + 64 + 8 * fq) = w;
                __builtin_amdgcn_sched_barrier(0);
            }
    }
};
struct EpiVT {
    static constexpr bool PERM = true;
    bf16_t* VT; const float* SSKV;
    DI void operator()(g8::Acc& acc, const g8::Unit& u, int wr, int wc, int fr, int fq) const {
        asm volatile("" : "+v"(fr), "+v"(fq));
        const int row0 = u.pm * 256 + wr * 64 + fr, col0 = u.pn * 256 + wc * 32 + 8 * fq;
        float rv[2][8];
#pragma unroll
        for (int bj = 0; bj < 2; ++bj) { const f32x4 a = *(const f32x4*)(SSKV + col0 + bj * 128), b = *(const f32x4*)(SSKV + col0 + bj * 128 + 4);
#pragma unroll
            for (int j = 0; j < 4; ++j) { rv[bj][j] = rsqrtf(a[j] * (1.f / 256.f) + 1e-6f); rv[bj][4 + j] = rsqrtf(b[j] * (1.f / 256.f) + 1e-6f); } }
#pragma unroll
        for (int ai = 0; ai < 2; ++ai)
#pragma unroll
            for (int m = 0; m < 4; ++m)
#pragma unroll
                for (int bj = 0; bj < 2; ++bj) { u32x4 w;
                    w.x = cvt_pk_bf16(acc[ai][bj][m][0][0] * rv[bj][0], acc[ai][bj][m][0][1] * rv[bj][1]); w.y = cvt_pk_bf16(acc[ai][bj][m][0][2] * rv[bj][2], acc[ai][bj][m][0][3] * rv[bj][3]);
                    w.z = cvt_pk_bf16(acc[ai][bj][m][1][0] * rv[bj][4], acc[ai][bj][m][1][1] * rv[bj][5]); w.w = cvt_pk_bf16(acc[ai][bj][m][1][2] * rv[bj][6], acc[ai][bj][m][1][3] * rv[bj][7]);
                    *(u32x4*)(VT + (size_t)(row0 + ai * 128 + m * 16) * NROW + col0 + bj * 128) = w; }
    }
};
struct ProbVT {
    const bf16_t* Wv; const bf16_t* ZZ; int G, c;
    DI bool next(int i, g8::Unit& u) const { const int L = i * G + c; if (L >= 144) return false; u.pn = L >> 1; u.pm = L & 1; u.ty = 0; u.e = 0; u.aux = 0; return true; }
    DI void addr(const g8::Unit& u, const int (&R)[2], const int (&C)[2], const int (&Rb)[2], g8::Addr& a) const {
        g8::addr_plain(a, Wv + (size_t)u.pm * 256 * 256, 512u, ZZ + (size_t)u.pn * 256 * 1280 + 768, 2560u, 4, R, C, Rb);
    }
};
DI void phase_qkv(const Params& p, LAS unsigned char* lds, int dry = 0) {
    const int G = gridDim.x, c = blockIdx.x;
    const float* rope = (const float*)(p.ws + WS_ROPE);
    {   ProbPlain P{p.ws + WS_ZZ, p.ws + WS_WUQ, 2560u, 1536u, 64, 3, 12, G, c};
        EpiQ E{(bf16_t*)(p.ws + WS_Q), (const float*)(p.ws + CTL_SSQ), (float*)(p.ws + CTL_HSS), p.in[I_QNGAIN], rope, dry};
        g8::gemm_phase(lds, P, E); }
    {   ProbS5 P{(const bf16_t*)(p.ws + WS_UC), (const bf16_t*)(p.ws + WS_S5WEND), 5, 4, 512u, (size_t)256 * 256, G, (c + 192) % G};
        EpiSend E{(float*)(p.ws + WS_SEND)};
        g8::gemm_phase(lds, P, E); }
    {   ProbPlain P{p.ws + WS_ZZ + 768 * 2, p.ws + WS_WUK, 2560u, 512u, 72, 2, 4, G, (c + 96) % G};
        EpiK E{(bf16_t*)(p.ws + WS_K), (const bf16_t*)(p.ws + WS_ZZ), (const float*)(p.ws + CTL_SSKV), p.in[I_KNGAIN], rope};
        g8::gemm_phase(lds, P, E); }
    {   ProbVT P{(const bf16_t*)(p.ws + WS_WUV), (const bf16_t*)(p.ws + WS_ZZ), G, (c + 240) % G};
        EpiVT E{(bf16_t*)(p.ws + WS_VT), (const float*)(p.ws + CTL_SSKV)};
        g8::gemm_phase(lds, P, E); }
}

DI void s5_carry_scan(const Params& p) {
    const int tid_ = my_tid(); const int lane = tid_ & 63, wave = __builtin_amdgcn_readfirstlane(tid_ >> 6);
    if (wave >= 2) return;
    const int task = blockIdx.x * 2 + wave; if (task >= 512) return;
    const int b = task & 7, g = (task >> 3) & 31, d = task >> 8;
    const f32x2 a16 = *(const f32x2*)((const float*)(p.ws + WS_S5A16) + (size_t)((d * 32 + g) * 64 + lane) * 2);
    const float* S = (const float*)(p.ws + WS_SEND) + (size_t)g * 1280 * 256 + d * 128 + lane * 2;
    bf16_t* Cy = (bf16_t*)(p.ws + WS_UC) + (size_t)g * 1280 * 512 + 256 + d * 128 + lane * 2;
    float hr = 0.f, hi = 0.f;
    for (int blk = 0; blk < 144; blk += 16) {
        f32x2 sv[16]; int rr[16];
#pragma unroll
        for (int k = 0; k < 16; ++k) { const int st = blk + k;
            const int r = st < 16 ? 1024 + b * 16 + (d ? 15 - st : st) : b * 128 + (d ? 143 - st : st - 16);
            rr[k] = r; sv[k] = *(const f32x2*)(S + (size_t)r * 256); }
#pragma unroll
        for (int k = 0; k < 16; ++k) {
            *(unsigned*)(Cy + (size_t)rr[k] * 512) = cvt_pk_bf16(hr, hi);
            const float nr = a16[0] * hr - a16[1] * hi + sv[k][0], ni = a16[0] * hi + a16[1] * hr + sv[k][1];
            hr = nr; hi = ni;
        }
    }
}
DI void phase_attn(const Params& p, LAS unsigned char* lds) {
    s5_carry_scan(p);
    const int tid = my_tid(), lane = tid & 63, wave = __builtin_amdgcn_readfirstlane(tid >> 6), r = lane & 31, hh = lane >> 5;
    const bf16_t* Q = (const bf16_t*)(p.ws + WS_Q); const bf16_t* K = (const bf16_t*)(p.ws + WS_K); const bf16_t* VT = (const bf16_t*)(p.ws + WS_VT);
    const float* HSS = (const float*)(p.ws + CTL_HSS); bf16_t* O = (bf16_t*)(p.ws + WS_MIXCD);
    constexpr int KS = 208, VS = 144, KB = 64 * KS, VB = 64 * VS, BUF = KB + VB;
    for (int L = blockIdx.x; L < 512; L += gridDim.x) {
        const int bh = L >> 3, qt = L & 7, b = bh >> 3, h = bh & 7;
        const int qrow = b * 2048 + qt * 256 + wave * 32 + r;
        const float qs = rsqrtf(HSS[(size_t)qrow * 8 + h] * (1.f / 96.f) + 1e-6f) * (0.10206207261596577f * 1.4426950408889634f);
        bf16x8 qf[6];
#pragma unroll
        for (int ks = 0; ks < 6; ++ks) { const u32x4 v = *(const u32x4*)(Q + (size_t)qrow * 768 + h * 96 + ks * 16 + 8 * hh);
            u32x4 w; w.x = pk_bf16(bf_lo(v.x) * qs, bf_hi(v.x) * qs); w.y = pk_bf16(bf_lo(v.y) * qs, bf_hi(v.y) * qs); w.z = pk_bf16(bf_lo(v.z) * qs, bf_hi(v.z) * qs); w.w = pk_bf16(bf_lo(v.w) * qs, bf_hi(v.w) * qs);
            qf[ks] = __builtin_bit_cast(bf16x8, w); }
        f32x16 ot[2];
#pragma unroll
        for (int i = 0; i < 16; ++i) { ot[0][i] = 0.f; ot[1][i] = 0.f; }
        float mrun = -1.0e30f, lrun = 0.f;
        const int kk0 = tid / 12, kp0 = tid - kk0 * 12, kk1 = (tid + 512) / 12, kp1 = (tid + 512) - kk1 * 12; const bool k2 = tid < 256;
        const int vd = tid >> 3, vp = tid & 7;
        u32x4 sk0, sk1 = (u32x4){0u, 0u, 0u, 0u}, sv;
        auto tokbase = [&](int t) { return t < 4 ? NLAT + b * 256 + t * 64 : b * 2048 + (t - 4) * 64; };
        auto gload = [&](int t) { const int tb = tokbase(t);
            sk0 = *(const u32x4*)(K + (size_t)(tb + kk0) * 768 + h * 96 + kp0 * 8);
            if (k2) sk1 = *(const u32x4*)(K + (size_t)(tb + kk1) * 768 + h * 96 + kp1 * 8);
            sv = *(const u32x4*)(VT + (size_t)(h * 64 + vd) * NROW + tb + vp * 8); };
        auto lstore = [&](int buf) { LAS unsigned char* bp = lds + buf * BUF;
            *(LAS u32x4*)(bp + kk0 * KS + kp0 * 16) = sk0; if (k2) *(LAS u32x4*)(bp + kk1 * KS + kp1 * 16) = sk1;
            *(LAS u32x4*)(bp + KB + vd * VS + vp * 16) = sv; };
        __syncthreads();
        gload(0); lstore(0);
        __syncthreads();
        for (int t = 0; t < 36; ++t) {
            if (t + 1 < 36) gload(t + 1);
            LAS const unsigned char* kb_ = lds + (t & 1) * BUF; LAS const unsigned char* vb_ = kb_ + KB;
            f32x16 st[2];
#pragma unroll
            for (int kb = 0; kb < 2; ++kb) {
#pragma unroll
                for (int i = 0; i < 16; ++i) st[kb][i] = 0.f;
#pragma unroll
                for (int ks = 0; ks < 6; ++ks) { const bf16x8 kf = *(const LAS bf16x8*)(kb_ + (kb * 32 + r) * KS + ks * 32 + hh * 16);
                    st[kb] = __builtin_amdgcn_mfma_f32_32x32x16_bf16(kf, qf[ks], st[kb], 0, 0, 0); }
            }
            float mx = st[0][0];
#pragma unroll
            for (int i = 0; i < 16; ++i) { mx = fmaxf(mx, st[0][i]); mx = fmaxf(mx, st[1][i]); }
            mx = fmaxf(mx, __shfl_xor(mx, 32));
            const float mnew = fmaxf(mrun, mx), alpha = fast_exp2(mrun - mnew);
            mrun = mnew;
            float ps = 0.f;
#pragma unroll
            for (int kb = 0; kb < 2; ++kb)
#pragma unroll
                for (int i = 0; i < 16; ++i) { st[kb][i] = fast_exp2(st[kb][i] - mnew); ps += st[kb][i]; }
            lrun = lrun * alpha + ps;
#pragma unroll
            for (int i = 0; i < 16; ++i) { ot[0][i] *= alpha; ot[1][i] *= alpha; }
#pragma unroll
            for (int kb = 0; kb < 2; ++kb)
#pragma unroll
                for (int s = 0; s < 2; ++s) {
                    u32x4 pw; pw.x = pk_bf16(st[kb][8 * s], st[kb][8 * s + 1]); pw.y = pk_bf16(st[kb][8 * s + 2], st[kb][8 * s + 3]); pw.z = pk_bf16(st[kb][8 * s + 4], st[kb][8 * s + 5]); pw.w = pk_bf16(st[kb][8 * s + 6], st[kb][8 * s + 7]);
                    const bf16x8 pf = __builtin_bit_cast(bf16x8, pw);
#pragma unroll
                    for (int db = 0; db < 2; ++db) {
                        const u32x2 v0 = *(const LAS u32x2*)(vb_ + (db * 32 + r) * VS + (kb * 32 + 16 * s + 4 * hh) * 2), v1 = *(const LAS u32x2*)(vb_ + (db * 32 + r) * VS + (kb * 32 + 16 * s + 8 + 4 * hh) * 2);
                        const u32x4 vw = (u32x4){v0.x, v0.y, v1.x, v1.y};
                        ot[db] = __builtin_amdgcn_mfma_f32_32x32x16_bf16(__builtin_bit_cast(bf16x8, vw), pf, ot[db], 0, 0, 0);
                    }
                }
            if (t + 1 < 36) lstore((t + 1) & 1);
            __syncthreads();
        }
        const float linv = 1.f / (lrun + __shfl_xor(lrun, 32));
#pragma unroll
        for (int db = 0; db < 2; ++db)
#pragma unroll
            for (int g4 = 0; g4 < 4; ++g4) { u32x2 w; w.x = pk_bf16(ot[db][4 * g4] * linv, ot[db][4 * g4 + 1] * linv); w.y = pk_bf16(ot[db][4 * g4 + 2] * linv, ot[db][4 * g4 + 3] * linv);
                *(u32x2*)(O + (size_t)qrow * 1024 + 512 + h * 64 + db * 32 + 8 * g4 + 4 * hh) = w; }
    }
}

struct EpiY {
    static constexpr bool PERM = true;
    bf16_t* Gb;
    DI void operator()(g8::Acc& acc, const g8::Unit& u, int wr, int wc, int fr, int fq) const {
        asm volatile("" : "+v"(fr), "+v"(fq));
        const int r0 = u.pm * 256 + wr * 64 + fr;
#pragma unroll
        for (int ai = 0; ai < 2; ++ai)
#pragma unroll
            for (int m = 0; m < 4; ++m)
#pragma unroll
                for (int bj = 0; bj < 2; ++bj) { const int col = bj * 128 + wc * 32 + 8 * fq, tok = (r0 + ai * 128 + m * 16) * 16 + (col >> 4);
                    g8::store8<1>(Gb + (size_t)tok * 512 + u.e * 16 + (col & 15), acc[ai][bj][m][0], acc[ai][bj][m][1]); __builtin_amdgcn_sched_barrier(0); }
    }
};
struct EpiGlu {
    static constexpr bool PERM = true;
    const bf16_t* Gb; bf16_t* MX;
    DI void operator()(g8::Acc& acc, const g8::Unit& u, int wr, int wc, int fr, int fq) const {
        asm volatile("" : "+v"(fr), "+v"(fq));
        const int row0 = u.pm * 256 + wr * 64 + fr, col0 = u.pn * 256 + wc * 32 + 8 * fq;
#pragma unroll
        for (int ai = 0; ai < 2; ++ai)
#pragma unroll
            for (int m = 0; m < 4; ++m)
#pragma unroll
                for (int bj = 0; bj < 2; ++bj) { const int row = row0 + ai * 128 + m * 16, col = col0 + bj * 128;
                    const u32x4 gv = *(const u32x4*)(Gb + (size_t)row * 512 + col);
                    const float gx[8] = {bf_lo(gv.x), bf_hi(gv.x), bf_lo(gv.y), bf_hi(gv.y), bf_lo(gv.z), bf_hi(gv.z), bf_lo(gv.w), bf_hi(gv.w)};
                    float x[8];
#pragma unroll
                    for (int j = 0; j < 4; ++j) { x[j] = gx[j] * sigm_f(acc[ai][bj][m][0][j]); x[4 + j] = gx[4 + j] * sigm_f(acc[ai][bj][m][1][j]); }
                    u32x4 w; w.x = cvt_pk_bf16(x[0], x[1]); w.y = cvt_pk_bf16(x[2], x[3]); w.z = cvt_pk_bf16(x[4], x[5]); w.w = cvt_pk_bf16(x[6], x[7]);
                    *(u32x4*)(MX + (size_t)row * 1024 + col) = w; __builtin_amdgcn_sched_barrier(0); }
    }
};
DI void phase_s5y(const Params& p, LAS unsigned char* lds) {
    ProbS5 P{(const bf16_t*)(p.ws + WS_UC), (const bf16_t*)(p.ws + WS_S5WY), 4, 8, 1024u, (size_t)256 * 512, (int)gridDim.x, (int)blockIdx.x};
    EpiY E{(bf16_t*)(p.ws + WS_G)};
    g8::gemm_phase(lds, P, E);
}
DI void phase_glu(const Params& p, LAS unsigned char* lds) {
    ProbPlain P{p.ws + WS_G, p.ws + WS_WGLU, 1024u, 1024u, 64, 2, 8, (int)gridDim.x, (int)blockIdx.x};
    EpiGlu E{(const bf16_t*)(p.ws + WS_G), (bf16_t*)(p.ws + WS_MIXCD)};
    g8::gemm_phase(lds, P, E);
}
DI void phase_cdout(const Params& p, LAS unsigned char* lds) {
    ProbPlain P{p.ws + WS_MIXCD, p.ws + WS_WCDOUT, 2048u, 2048u, 64, 4, 16, (int)gridDim.x, (int)blockIdx.x};
    EpiResid E{p.out, (const float*)(p.ws + WS_XC), p.out, (float*)(p.ws + WS_XC), (const float*)(p.ws + WS_MOD) + 9 * 6144 + 2048, (float*)(p.ws + CTL_SS2), 0};
    g8::gemm_phase(lds, P, E);
}
DI Params load_params(LAS unsigned char* lds) {
    LAS const unsigned long long* tab = (LAS const unsigned long long*)(lds + LDS_MISC + 512);
    Params q;
#pragma unroll
    for (int i = 0; i < 37; ++i) { const unsigned long long v = tab[i]; q.in[i] = (const float*)(((unsigned long long)(unsigned)__builtin_amdgcn_readfirstlane((int)(v >> 32)) << 32) | (unsigned)__builtin_amdgcn_readfirstlane((int)v)); }
    { const unsigned long long v = tab[37]; q.out = (float*)(((unsigned long long)(unsigned)__builtin_amdgcn_readfirstlane((int)(v >> 32)) << 32) | (unsigned)__builtin_amdgcn_readfirstlane((int)v)); }
    { const unsigned long long v = tab[38]; q.ws = (unsigned char*)(((unsigned long long)(unsigned)__builtin_amdgcn_readfirstlane((int)(v >> 32)) << 32) | (unsigned)__builtin_amdgcn_readfirstlane((int)v)); }
    return q;
}
#define PHASE(call) do { const Params q = load_params(lds); call; } while (0)
#define GRIDBAR() do { XcdBarrier bar; bar.bar = barw; bar.x = xcc; bar.st = (volatile LAS unsigned*)(lds + LDS_MISC); xcd_barrier(bar); } while (0)
__global__ __launch_bounds__(512, 2) void k_fwd(Params pdummy) {
    extern __shared__ __attribute__((aligned(16))) unsigned char shm[];
    LAS unsigned char* lds = (LAS unsigned char*)shm;
    {   const int tid = my_tid();
        const unsigned long long* ka = (const unsigned long long*)__builtin_amdgcn_kernarg_segment_ptr();
        if (tid < 39) ((LAS unsigned long long*)(lds + LDS_MISC + 512))[tid] = ka[tid];
        if (tid == 0) *(LAS u32x4*)(lds + LDS_MISC) = (u32x4){0u, 0u, 0u, 0u};
    }
    __syncthreads();
    unsigned* barw; unsigned xcc;
    {   const Params q = load_params(lds); barw = (unsigned*)(q.ws + CTL_BAR);
        const XcdBarrier b0 = xcd_barrier_post(barw, (volatile LAS unsigned*)(lds + LDS_MISC)); xcc = b0.x; }
    PHASE(phase_p0(q, lds));          GRIDBAR();
    PHASE(phase_p1(q));               GRIDBAR();
    PHASE(phase_p2(q, lds));          GRIDBAR();
    PHASE(phase_p3(q, lds));          GRIDBAR();
    PHASE(phase_p4(q, lds));          GRIDBAR();
    PHASE(phase_router<0>(q, lds));   GRIDBAR();
    PHASE(phase_moe1<0>(q, lds));     GRIDBAR();
    PHASE(phase_moe2<0>(q, lds));     GRIDBAR();
    PHASE(phase_combine<0>(q, lds));  GRIDBAR();
    PHASE(phase_cdin(q, lds));        GRIDBAR();
    PHASE(phase_qkv(q, lds));         GRIDBAR();
    PHASE(phase_attn(q, lds));        GRIDBAR();
    PHASE(phase_s5y(q, lds));         GRIDBAR();
    PHASE(phase_glu(q, lds));         GRIDBAR();
    PHASE(phase_cdout(q, lds));       GRIDBAR();
    PHASE(phase_router<1>(q, lds));   GRIDBAR();
    PHASE(phase_moe1<1>(q, lds));     GRIDBAR();
    PHASE(phase_moe2<1>(q, lds));     GRIDBAR();
    PHASE(phase_combine<1>(q, lds));
    (void)pdummy;
}
static const int kDynLds = 160 * 1024;
extern "C" void kernel_launch(void* const* d_in, const int* in_sizes, int n_in, void* d_out, int out_size, void* d_ws, size_t ws_size, hipStream_t stream) {
    Params p{};
    for (int i = 0; i < 37; ++i) p.in[i] = (const float*)d_in[i];
    p.out = (float*)d_out; p.ws = (unsigned char*)d_ws;
    (void)ws_size; (void)in_sizes; (void)n_in; (void)out_size;
    static int grid = 0;
    if (!grid) {
        int dev = 0, cus = 0, per_cu = 0;
        (void)hipGetDevice(&dev);
        (void)hipDeviceGetAttribute(&cus, hipDeviceAttributeMultiprocessorCount, dev);
        (void)hipFuncSetAttribute((const void*)k_fwd, hipFuncAttributeMaxDynamicSharedMemorySize, kDynLds);
        (void)hipOccupancyMaxActiveBlocksPerMultiprocessor(&per_cu, (const void*)k_fwd, 512, kDynLds);
        grid = cus > 0 ? cus : 256;
        if (per_cu < 1) fprintf(stderr, "kernel_launch: occupancy query reports %d workgroups per CU\n", per_cu);
    }
    (void)hipMemsetAsync(d_ws, 0, CTL_BYTES, stream);
    hipLaunchKernelGGL(k_fwd, dim3(grid), dim3(512), kDynLds, stream, p);
}
```

```cpp
#include <hip/hip_runtime.h>
#include <stdint.h>
#include <stdio.h>

#define NLAT 16384
#define NCTX 2048
#define NROW 18432
#define LAS __attribute__((address_space(3)))
typedef unsigned short bf16_t;
typedef short bf16x8 __attribute__((ext_vector_type(8)));
typedef float f32x4 __attribute__((ext_vector_type(4)));
typedef float f32x2 __attribute__((ext_vector_type(2)));
typedef float f32x16 __attribute__((ext_vector_type(16)));
typedef unsigned u32x4 __attribute__((ext_vector_type(4)));
typedef unsigned u32x2 __attribute__((ext_vector_type(2)));
#define DI __device__ __forceinline__

DI unsigned cvt_pk_bf16(float lo, float hi) { unsigned r; asm volatile("v_cvt_pk_bf16_f32 %0, %1, %2" : "=v"(r) : "v"(lo), "v"(hi)); return r; }
DI float bf_lo(unsigned w) { return __uint_as_float(w << 16); }
DI float bf_hi(unsigned w) { return __uint_as_float(w & 0xffff0000u); }
DI float bf2f(bf16_t b) { return __uint_as_float(((unsigned)b) << 16); }
DI float fast_exp2(float x) { return __builtin_amdgcn_exp2f(x); }
DI float fast_rcp(float x) { return __builtin_amdgcn_rcpf(x); }
DI float gelu_f(float x) { const float u = x * (0.7978845608f + 0.0356774081f * x * x); return x * fast_rcp(1.f + fast_exp2(-2.885390082f * u)); }
DI float gelu_ns(float x) { float x2; asm volatile("v_mul_f32 %0, %1, %1" : "=v"(x2) : "v"(x)); const float u = x * (0.7978845608f + 0.0356774081f * x2); return x * fast_rcp(1.f + fast_exp2(-2.885390082f * u)); }
DI float silu_f(float x) { return x * fast_rcp(1.f + fast_exp2(-1.442695041f * x)); }
DI float sigm_f(float x) { return fast_rcp(1.f + fast_exp2(-1.442695041f * x)); }
DI int my_tid() { int t = threadIdx.x; asm volatile("" : "+v"(t)); return t; }
DI int modrow(int r) { return r < NLAT ? (r >> 11) : 8; }
DI float wave_sum(float v) {
#pragma unroll
    for (int o = 1; o < 64; o <<= 1) v += __shfl_xor(v, o);
    return v;
}

#define XB_TMO      128
#define XB_XCNT(j)  (256  + 64 * (j))
#define XB_XSUB(j)  (1280 + 64 * (j))
#define XB_XGEN(j)  (2304 + 64 * (j))
#define XB_TOP      3328
#define XB_TOPGEN   3392
#define XCD_BAR_WORDS 3456
#define XB_SPIN_CAP (1u << 18)
DI unsigned xb_ld(unsigned* p)              { return __hip_atomic_load(p, __ATOMIC_RELAXED, __HIP_MEMORY_SCOPE_AGENT); }
DI unsigned xb_add(unsigned* p, unsigned v) { return __hip_atomic_fetch_add(p, v, __ATOMIC_RELAXED, __HIP_MEMORY_SCOPE_AGENT); }
DI unsigned xb_xcc_id() { return (unsigned)__builtin_amdgcn_s_getreg((3 << 11) | 20) & 0xFu; }
#define XB_SPIN(cond, bar) do { unsigned _sp = 0; while (cond) { __builtin_amdgcn_s_sleep(1); \
    if ((++_sp & 255u) == 0u) { if (xb_ld(&(bar)[XB_TMO])) break; if (_sp > XB_SPIN_CAP) { atomicAdd(&(bar)[XB_TMO], 1u); break; } } } } while (0)
struct XcdBarrier { unsigned* bar; unsigned x; volatile LAS unsigned* st; };
DI XcdBarrier xcd_barrier_post(unsigned* bar, volatile LAS unsigned* st) {
    XcdBarrier b; b.bar = bar; b.x = xb_xcc_id(); b.st = st;
    if (threadIdx.x == 0) (void)xb_add(&bar[XB_XCNT(b.x)], 1u);
    return b;
}
DI void xcd_barrier_complete(unsigned* bar, unsigned x, unsigned& nloc, unsigned& nx) {
    const unsigned G = gridDim.x * gridDim.y * gridDim.z;
    unsigned sum, cnt, mine, sp = 0u;
    for (;;) {
        sum = 0u; cnt = 0u; mine = 0u;
#pragma unroll
        for (unsigned j = 0; j < 16; ++j) { const unsigned c = xb_ld(&bar[XB_XCNT(j)]); sum += c; cnt += (c > 0u) ? 1u : 0u; mine = (j == x) ? c : mine; }
        if (sum == G) break;
        __builtin_amdgcn_s_sleep(1);
        if ((++sp & 255u) == 0u) { if (xb_ld(&bar[XB_TMO])) break; if (sp > XB_SPIN_CAP) { atomicAdd(&bar[XB_TMO], 1u); break; } }
    }
    nloc = mine > 0u ? mine : 1u; nx = cnt > 0u ? cnt : 1u;
}
DI void xcd_barrier(const XcdBarrier& b) {
    asm volatile("s_waitcnt vmcnt(0)" ::: "memory");
    __syncthreads();
    if (threadIdx.x == 0) {
        unsigned* bar = b.bar;
        __builtin_amdgcn_s_waitcnt(0);
        unsigned nloc = b.st[0], nx = b.st[1];
        if (nloc == 0u) { xcd_barrier_complete(bar, b.x, nloc, nx); b.st[0] = nloc; b.st[1] = nx; }
        const unsigned old = xb_add(&bar[XB_XSUB(b.x)], 1u);
        const unsigned gen = old / nloc;
        if (old + 1u == (gen + 1u) * nloc) {
            __builtin_amdgcn_fence(__ATOMIC_RELEASE, "agent");
            asm volatile("s_waitcnt vmcnt(0)" ::: "memory");
            const unsigned og = xb_add(&bar[XB_TOP], 1u);
            const unsigned tg = og / nx;
            if (og + 1u == (tg + 1u) * nx) xb_add(&bar[XB_TOPGEN], 1u);
            else XB_SPIN(xb_ld(&bar[XB_TOPGEN]) == tg, bar);
            __builtin_amdgcn_fence(__ATOMIC_ACQUIRE, "agent");
            xb_add(&bar[XB_XGEN(b.x)], 1u);
            asm volatile("s_waitcnt vmcnt(0)" ::: "memory");
        } else {
            XB_SPIN(xb_ld(&bar[XB_XGEN(b.x)]) == gen, bar);
            __builtin_amdgcn_fence(__ATOMIC_ACQUIRE, "agent");
            asm volatile("s_waitcnt vmcnt(0)" ::: "memory");
        }
    }
    __syncthreads();
}

namespace g8 {
constexpr int BM = 256, BK = 64, HALF = 128, HTB = HALF * BK * 2, STAGE_BYTES = 8 * HTB;
__host__ __device__ __forceinline__ int lds_byte(int r, int c) { const int st = (r >> 4) * 2 + (c >> 5), rr = r & 15, cc = c & 31, ob = rr * 64 + cc * 2; return st * 1024 + (ob ^ (((ob >> 9) & 1) << 5)); }
__host__ __device__ __forceinline__ void stage_rc(int b, int& R, int& C) { const int st = b / 1024, sb = b % 1024, swz = sb ^ (((sb >> 9) & 1) << 5); R = (st >> 1) * 16 + swz / 64; C = (st & 1) * 32 + (swz % 64) / 2; }
__host__ __device__ __forceinline__ int perm32(int rho) { const int n = rho >> 4, i = rho & 15; return 8 * (i >> 2) + 4 * n + (i & 3); }

struct Unit { int ty, pm, pn, e, aux; };
struct Addr { const char* A; const char* B; unsigned vA[2][2]; unsigned vB[2]; unsigned hsB; unsigned ksA, ksB; int nt; };
typedef f32x4 Acc[2][2][4][2];

template <class P, class E>
__device__ __forceinline__ void gemm_phase(LAS unsigned char* lds, const P& prob, const E& epi) {
    const int tid = my_tid(), wid = __builtin_amdgcn_readfirstlane(tid >> 6), lane = tid & 63, wr = wid >> 2, wc = wid & 3, fr = lane & 15, fq = lane >> 4;
    int R[2], C[2], Rb[2];
#pragma unroll
    for (int i = 0; i < 2; ++i) { stage_rc(tid * 16 + i * 8192, R[i], C[i]); Rb[i] = E::PERM ? ((R[i] & ~31) + perm32(R[i] & 31)) : R[i]; }
    const unsigned ldsw = (unsigned)wid * 1024u;
    const int aoff = lds_byte(wr * 64 + fr, fq * 8), boff = lds_byte(wc * 32 + fr, fq * 8);
#define G8_SA(b, h) (((b) * 2 + (h)) * HTB)
#define G8_SB(b, h) ((4 + (b) * 2 + (h)) * HTB)
#define G8_STAGE(bufoff, gbase, voff) do { _Pragma("unroll") for (int _i = 0; _i < 2; ++_i) \
        __builtin_amdgcn_global_load_lds((const unsigned*)((const char*)(gbase) + (voff)[_i]), (LAS unsigned*)(lds + (bufoff) + ldsw + _i * 8192), 16, 0, 0); } while (0)
#define G8_LDA(dst, b, h) do { _Pragma("unroll") for (int m = 0; m < 4; ++m) _Pragma("unroll") for (int k = 0; k < 2; ++k) dst[m][k] = *(const LAS bf16x8*)(lds + G8_SA(b, h) + aoff + m * 2048 + k * 1024); } while (0)
#define G8_LDB(dst, b, h) do { _Pragma("unroll") for (int n = 0; n < 2; ++n) _Pragma("unroll") for (int k = 0; k < 2; ++k) dst[n][k] = *(const LAS bf16x8*)(lds + G8_SB(b, h) + boff + n * 2048 + k * 1024); } while (0)
#define G8_MMA(ai, bj, At, Bt) do { __builtin_amdgcn_s_setprio(1); _Pragma("unroll") for (int m = 0; m < 4; ++m) _Pragma("unroll") for (int n = 0; n < 2; ++n) _Pragma("unroll") for (int k = 0; k < 2; ++k) \
        acc[ai][bj][m][n] = __builtin_amdgcn_mfma_f32_16x16x32_bf16(Bt[n][k], At[m][k], acc[ai][bj][m][n], 0, 0, 0); __builtin_amdgcn_s_setprio(0); } while (0)
#define G8_WAIT_V(n) asm volatile("s_waitcnt vmcnt(" #n ")" ::: "memory")
#define G8_WAIT_L(n) asm volatile("s_waitcnt lgkmcnt(" #n ")" ::: "memory")
#define G8_BAR __builtin_amdgcn_s_barrier()
#define G8_SCHED __builtin_amdgcn_sched_barrier(0)
    Unit cur, nxt; int ui = 0;
    if (!prob.next(0, cur)) return;
    Addr ca;
    prob.addr(cur, R, C, Rb, ca);
    f32x4 acc[2][2][4][2];
#pragma unroll
    for (int a = 0; a < 2; ++a)
#pragma unroll
        for (int b = 0; b < 2; ++b)
#pragma unroll
            for (int m = 0; m < 4; ++m)
#pragma unroll
                for (int n = 0; n < 2; ++n) acc[a][b][m][n] = (f32x4){0.f, 0.f, 0.f, 0.f};
    bf16x8 At[4][2], B0[2][2], B1[2][2];
    G8_STAGE(G8_SB(0, 0), ca.B, ca.vB); G8_STAGE(G8_SA(0, 0), ca.A, ca.vA[0]); G8_STAGE(G8_SB(0, 1), ca.B + ca.hsB, ca.vB); G8_STAGE(G8_SA(0, 1), ca.A, ca.vA[1]);
    if (wr == 1) G8_BAR;
    G8_WAIT_V(4); G8_BAR;
    G8_STAGE(G8_SB(1, 0), ca.B + ca.ksB, ca.vB); G8_STAGE(G8_SA(1, 0), ca.A + ca.ksA, ca.vA[0]); G8_STAGE(G8_SB(1, 1), ca.B + ca.hsB + ca.ksB, ca.vB);
    G8_WAIT_V(6); G8_BAR;
    const char* nA = ca.A; const char* nB = ca.B; unsigned nhsB = ca.hsB, nksA = ca.ksA, nksB = ca.ksB; int nnt = ca.nt;
    for (;;) {
        const bool has_next = prob.next(ui + 1, nxt);
        const int nt = ca.nt;
        for (int t = 0; t < nt; t += 2) {
            const bool last = (t == nt - 2);
            const char* a1 = ca.A + (size_t)(t + 1) * ca.ksA;
            G8_LDB(B0, 0, 0); G8_SCHED; G8_LDA(At, 0, 0); G8_STAGE(G8_SA(1, 1), a1, ca.vA[1]);
            if (last) {
                if (has_next) { Addr tn; prob.addr(nxt, R, C, Rb, tn); nA = tn.A; nB = tn.B; nhsB = tn.hsB; nksA = tn.ksA; nksB = tn.ksB; nnt = tn.nt;
#pragma unroll
                    for (int i = 0; i < 2; ++i) { ca.vA[0][i] = tn.vA[0][i]; ca.vA[1][i] = tn.vA[1][i]; ca.vB[i] = tn.vB[i]; } }
                else { nA = ca.A; nB = ca.B; nhsB = ca.hsB; nksA = ca.ksA; nksB = ca.ksB; nnt = ca.nt; }
            }
            const char* a2 = last ? nA : ca.A + (size_t)(t + 2) * ca.ksA; const char* b2 = last ? nB : ca.B + (size_t)(t + 2) * ca.ksB;
            const char* a3 = a2 + (last ? nksA : ca.ksA); const char* b3 = b2 + (last ? nksB : ca.ksB);
            const unsigned hb = last ? nhsB : ca.hsB;
            G8_WAIT_L(8); G8_BAR; G8_WAIT_L(0); G8_MMA(0, 0, At, B0); G8_BAR; G8_SCHED;
            G8_LDB(B1, 0, 1); G8_STAGE(G8_SB(0, 0), b2, ca.vB);
            G8_BAR; G8_WAIT_L(0); G8_MMA(0, 1, At, B1); G8_BAR;
            G8_LDA(At, 0, 1); G8_STAGE(G8_SA(0, 0), a2, ca.vA[0]);
            G8_BAR; G8_WAIT_L(0); G8_MMA(1, 0, At, B0); G8_BAR; G8_SCHED;
            G8_STAGE(G8_SB(0, 1), b2 + hb, ca.vB);
            G8_WAIT_V(6); G8_BAR; G8_MMA(1, 1, At, B1); G8_BAR;
            G8_LDB(B0, 1, 0); G8_SCHED; G8_LDA(At, 1, 0); G8_STAGE(G8_SA(0, 1), a2, ca.vA[1]);
            G8_WAIT_L(8); G8_BAR; G8_WAIT_L(0); G8_MMA(0, 0, At, B0); G8_BAR; G8_SCHED;
            G8_LDB(B1, 1, 1); G8_STAGE(G8_SB(1, 0), b3, ca.vB);
            G8_BAR; G8_WAIT_L(0); G8_MMA(0, 1, At, B1); G8_BAR;
            G8_LDA(At, 1, 1); G8_STAGE(G8_SA(1, 0), a3, ca.vA[0]);
            G8_BAR; G8_WAIT_L(0); G8_MMA(1, 0, At, B0); G8_BAR; G8_SCHED;
            G8_STAGE(G8_SB(1, 1), b3 + hb, ca.vB);
            G8_WAIT_V(6); G8_BAR; G8_MMA(1, 1, At, B1); G8_BAR;
        }
        epi(acc, cur, wr, wc, fr, fq);
        if (!has_next) break;
#pragma unroll
        for (int a = 0; a < 2; ++a)
#pragma unroll
            for (int b = 0; b < 2; ++b)
#pragma unroll
                for (int m = 0; m < 4; ++m)
#pragma unroll
                    for (int n = 0; n < 2; ++n) acc[a][b][m][n] = (f32x4){0.f, 0.f, 0.f, 0.f};
        cur = nxt; ca.A = nA; ca.B = nB; ca.hsB = nhsB; ca.ksA = nksA; ca.ksB = nksB; ca.nt = nnt; ++ui;
    }
    G8_WAIT_V(0);
    if (wr == 0) G8_BAR;
    G8_BAR;
#undef G8_SA
#undef G8_SB
#undef G8_STAGE
#undef G8_LDA
#undef G8_LDB
#undef G8_MMA
#undef G8_WAIT_V
#undef G8_WAIT_L
#undef G8_BAR
#undef G8_SCHED
}

DI void addr_plain(Addr& a, const void* Abase, unsigned sA, const void* Bbase, unsigned sB, int nt, const int (&R)[2], const int (&C)[2], const int (&Rb)[2]) {
    a.A = (const char*)Abase; a.B = (const char*)Bbase; a.ksA = 128u; a.ksB = 128u; a.nt = nt; a.hsB = 128u * sB;
#pragma unroll
    for (int i = 0; i < 2; ++i) { a.vA[0][i] = (unsigned)R[i] * sA + (unsigned)C[i] * 2u; a.vA[1][i] = a.vA[0][i] + 128u * sA; a.vB[i] = (unsigned)Rb[i] * sB + (unsigned)C[i] * 2u; }
}
template <int ACT> DI void store8(bf16_t* p, const f32x4& v0, const f32x4& v1) {
    float x[8] = {v0[0], v0[1], v0[2], v0[3], v1[0], v1[1], v1[2], v1[3]};
    if (ACT == 1) {
#pragma unroll
        for (int j = 0; j < 8; ++j) x[j] = gelu_f(x[j]);
    }
    u32x4 w; w.x = cvt_pk_bf16(x[0], x[1]); w.y = cvt_pk_bf16(x[2], x[3]); w.z = cvt_pk_bf16(x[4], x[5]); w.w = cvt_pk_bf16(x[6], x[7]);
    *(u32x4*)p = w;
}
}
struct Params { const float* in[37]; float* out; unsigned char* ws; };
enum { I_X = 0, I_C, I_CTX, I_CCTX, I_ADAW, I_ADAB, I_ABWIN, I_SGUNORM, I_SGUW, I_SGUB, I_CONVW, I_ABWOUT, I_CDWIN, I_S5ARE, I_S5AIM, I_S5LOGDT, I_S5BRE, I_S5BIM, I_S5CRE, I_S5CIM,
       I_S5D, I_S5WGLU, I_QNORM, I_KVNORM, I_WUQ, I_WUK, I_WUV, I_QNGAIN, I_KNGAIN, I_CDWOUT, I_WGRP, I_BGRP, I_WEXP, I_BEXP, I_WGATE, I_WUP, I_WDOWN };
constexpr size_t AL(size_t x) { return (x + 255) & ~(size_t)255; }
constexpr size_t CTL_BAR = 0;
constexpr size_t CTL_CNT = 16384;
constexpr size_t CTL_VSS = 32768;
constexpr size_t CTL_SS1 = CTL_VSS + NROW * 4;
constexpr size_t CTL_SS2 = CTL_SS1 + NROW * 4;
constexpr size_t CTL_SSQ = CTL_SS2 + NROW * 4;
constexpr size_t CTL_SSKV = CTL_SSQ + NROW * 4;
constexpr size_t CTL_HSS = CTL_SSKV + NROW * 4;
constexpr size_t CTL_BYTES = AL(CTL_HSS + (size_t)NLAT * 8 * 4);
constexpr size_t WS_MOD = CTL_BYTES;
constexpr size_t WS_ROPE = AL(WS_MOD + 2 * 9 * 6144 * 4);
constexpr size_t WS_WRT = AL(WS_ROPE + 2 * 64 * 8 * 4);
constexpr size_t WS_S5A16 = AL(WS_WRT + (size_t)2 * 36 * 1024 * 4);
constexpr size_t WS_WABIN = AL(WS_S5A16 + (size_t)2 * 32 * 64 * 2 * 4);
constexpr size_t WS_WABOUT = AL(WS_WABIN + (size_t)5120 * 1024 * 2);
constexpr size_t WS_WCDIN = AL(WS_WABOUT + (size_t)1024 * 2048 * 2);
constexpr size_t WS_WGLU = AL(WS_WCDIN + (size_t)1792 * 1024 * 2);
constexpr size_t WS_WUQ = AL(WS_WGLU + (size_t)512 * 512 * 2);
constexpr size_t WS_WUK = AL(WS_WUQ + (size_t)768 * 768 * 2);
constexpr size_t WS_WUV = AL(WS_WUK + (size_t)512 * 256 * 2);
constexpr size_t WS_WCDOUT = AL(WS_WUV + (size_t)512 * 256 * 2);
constexpr size_t WS_S5WEND = AL(WS_WCDOUT + (size_t)1024 * 1024 * 2);
constexpr size_t WS_S5WY = AL(WS_S5WEND + (size_t)32 * 256 * 256 * 2);
constexpr size_t WS_W1 = AL(WS_S5WY + (size_t)32 * 256 * 512 * 2);
constexpr size_t WS_W2 = AL(WS_W1 + (size_t)32 * 1024 * 1024 * 2);
constexpr size_t WS_W1B = AL(WS_W2 + (size_t)32 * 1024 * 512 * 2);
constexpr size_t WS_W2B = AL(WS_W1B + (size_t)32 * 1024 * 1024 * 2);
constexpr size_t WS_XC = AL(WS_W2B + (size_t)32 * 1024 * 512 * 2);
constexpr size_t WS_HB = AL(WS_XC + (size_t)NCTX * 1024 * 4);
constexpr size_t WS_ROUTE = AL(WS_HB + (size_t)NROW * 1024 * 2);
constexpr size_t WS_RWT = AL(WS_ROUTE + (size_t)NROW * 16);
constexpr size_t WS_LIST = AL(WS_RWT + (size_t)NROW * 8);
constexpr size_t WS_SCR = AL(WS_LIST + (size_t)32 * NROW * 4);
constexpr size_t WS_ZU = WS_SCR;
constexpr size_t WS_GVT = AL(WS_ZU + (size_t)NROW * 1024 * 2);
constexpr size_t WS_ZB = AL(WS_GVT + (size_t)NROW * 1024 * 2);
constexpr size_t WS_MIX = AL(WS_ZB + (size_t)NROW * 3072 * 2);
constexpr size_t WS_L0END = AL(WS_MIX + (size_t)NROW * 2048 * 2);
constexpr int MOE_ROWS = 2 * NROW + 32 * 256;
constexpr size_t WS_HID = WS_SCR;
constexpr size_t WS_YS = AL(WS_HID + (size_t)MOE_ROWS * 512 * 2);
constexpr size_t WS_MOEEND = AL(WS_YS + (size_t)MOE_ROWS * 1024 * 2);
constexpr size_t WS_ZZ = WS_SCR;
constexpr size_t WS_UC = AL(WS_ZZ + (size_t)NROW * 1280 * 2);
constexpr size_t WS_SEND = AL(WS_UC + (size_t)32 * 1280 * 512 * 2);
constexpr size_t WS_Q = AL(WS_SEND + (size_t)32 * 1280 * 256 * 4);
constexpr size_t WS_K = AL(WS_Q + (size_t)NLAT * 768 * 2);
constexpr size_t WS_VT = AL(WS_K + (size_t)NROW * 768 * 2);
constexpr size_t WS_G = AL(WS_VT + (size_t)512 * NROW * 2);
constexpr size_t WS_MIXCD = AL(WS_G + (size_t)NLAT * 512 * 2);
constexpr size_t WS_L1END = AL(WS_MIXCD + (size_t)NLAT * 1024 * 2);
DI void sincos_f64(double x, double& s, double& c) {
    const double twopi = 6.283185307179586476925286766559;
    const double r = x - twopi * rint(x / twopi);
    const double r2 = r * r;
    double ts = 1.0, tc = 1.0;
#pragma unroll
    for (int k = 14; k >= 1; --k) { ts = 1.0 - ts * r2 / (double)((2 * k) * (2 * k + 1)); tc = 1.0 - tc * r2 / (double)((2 * k - 1) * (2 * k)); }
    s = r * ts; c = tc;
}
DI void s5_tables(const Params& p, LAS unsigned char* lds, int g) {
    const int tid = my_tid();
    LAS float* PW = (LAS float*)lds;
    LAS float* BB = PW + 2 * 64 * 17 * 2;
    LAS float* CC = BB + 2 * 64 * 16 * 2;
    LAS float* KL = CC + 2 * 16 * 64 * 2;
    if (tid < 128) {
        const int d = tid >> 6, pp = tid & 63, i = (d * 32 + g) * 64 + pp;
        const double dt = exp((double)p.in[I_S5LOGDT][d * 32 + g]);
        const double ar = (double)p.in[I_S5ARE][i], ai = (double)p.in[I_S5AIM][i];
        const double mag = exp(dt * ar); double sn, cs; sincos_f64(dt * ai, sn, cs);
        const double abr = mag * cs, abi = mag * sn;
        const double den = ar * ar + ai * ai, nr = abr - 1.0;
        const double fr = (nr * ar + abi * ai) / den, fi = (abi * ar - nr * ai) / den;
        double pr = 1.0, pi = 0.0;
        for (int k = 0; k <= 16; ++k) { PW[((d * 64 + pp) * 17 + k) * 2] = (float)pr; PW[((d * 64 + pp) * 17 + k) * 2 + 1] = (float)pi; const double nr2 = pr * abr - pi * abi, ni2 = pr * abi + pi * abr; pr = nr2; pi = ni2; }
        float* a16 = (float*)(p.ws + WS_S5A16) + (size_t)i * 2;
        a16[0] = PW[((d * 64 + pp) * 17 + 16) * 2]; a16[1] = PW[((d * 64 + pp) * 17 + 16) * 2 + 1];
        for (int c = 0; c < 16; ++c) { const double br = (double)p.in[I_S5BRE][(size_t)i * 16 + c], bi = (double)p.in[I_S5BIM][(size_t)i * 16 + c];
            BB[((d * 64 + pp) * 16 + c) * 2] = (float)(fr * br - fi * bi); BB[((d * 64 + pp) * 16 + c) * 2 + 1] = (float)(fr * bi + fi * br); }
    }
    for (int i = tid; i < 2 * 16 * 64; i += 512) { const int d = i >> 10, r = i & 1023;
        const size_t src = (size_t)(d * 32 + g) * 1024 + r; CC[i * 2] = p.in[I_S5CRE][src]; CC[i * 2 + 1] = p.in[I_S5CIM][src]; }
    __syncthreads();
    for (int i = tid; i < 2 * 16 * 256; i += 512) {
        const int d = i >> 12, lag = (i >> 8) & 15, c = (i >> 4) & 15, c2 = i & 15;
        float acc = 0.f;
        for (int pp = 0; pp < 64; ++pp) {
            const float cr = CC[((d * 16 + c) * 64 + pp) * 2], ci = CC[((d * 16 + c) * 64 + pp) * 2 + 1];
            const float ar = PW[((d * 64 + pp) * 17 + lag) * 2], ai = PW[((d * 64 + pp) * 17 + lag) * 2 + 1];
            const float br = BB[((d * 64 + pp) * 16 + c2) * 2], bi = BB[((d * 64 + pp) * 16 + c2) * 2 + 1];
            const float tr = ar * br - ai * bi, ti = ar * bi + ai * br;
            acc += cr * tr - ci * ti;
        }
        KL[i] = acc;
    }
    __syncthreads();
    bf16_t* WY = (bf16_t*)(p.ws + WS_S5WY) + (size_t)g * 256 * 512;
    bf16_t* WE = (bf16_t*)(p.ws + WS_S5WEND) + (size_t)g * 256 * 256;
    const float* dsk = p.in[I_S5D] + g * 16;
    for (int i = tid; i < 256 * 512 / 2; i += 512) {
        const int n = i >> 8, k0 = (i & 255) * 2, s = n >> 4, c = n & 15;
        float v[2];
#pragma unroll
        for (int e = 0; e < 2; ++e) { const int k = k0 + e; float x;
            if (k < 256) { const int s2 = k >> 4, c2 = k & 15; x = 0.f;
                if (s2 <= s) x += KL[((0 * 16 + (s - s2)) * 16 + c) * 16 + c2];
                if (s2 >= s) x += KL[((1 * 16 + (s2 - s)) * 16 + c) * 16 + c2];
                if (s2 == s && c2 == c) x += dsk[c];
            } else { const int j = k - 256, d = j >> 7, pp = (j >> 1) & 63, im = j & 1, pw = d == 0 ? s + 1 : 16 - s;
                const float cr = CC[((d * 16 + c) * 64 + pp) * 2], ci = CC[((d * 16 + c) * 64 + pp) * 2 + 1];
                const float ar = PW[((d * 64 + pp) * 17 + pw) * 2], ai = PW[((d * 64 + pp) * 17 + pw) * 2 + 1];
                const float zr = cr * ar - ci * ai, zi = cr * ai + ci * ar;
                x = im ? -zi : zr; }
            v[e] = x; }
        *(unsigned*)(WY + (size_t)n * 512 + k0) = cvt_pk_bf16(v[0], v[1]);
    }
    for (int i = tid; i < 256 * 256 / 2; i += 512) {
        const int j = i >> 7, k0 = (i & 127) * 2, d = j >> 7, pp = (j >> 1) & 63, im = j & 1;
        float v[2];
#pragma unroll
        for (int e = 0; e < 2; ++e) { const int k = k0 + e, s2 = k >> 4, c2 = k & 15, pw = d == 0 ? 15 - s2 : s2;
            const float ar = PW[((d * 64 + pp) * 17 + pw) * 2], ai = PW[((d * 64 + pp) * 17 + pw) * 2 + 1];
            const float br = BB[((d * 64 + pp) * 16 + c2) * 2], bi = BB[((d * 64 + pp) * 16 + c2) * 2 + 1];
            v[e] = im ? (ar * bi + ai * br) : (ar * br - ai * bi); }
        *(unsigned*)(WE + (size_t)j * 256 + k0) = cvt_pk_bf16(v[0], v[1]);
    }
    __syncthreads();
}
DI int rowmap(int ty, int n) {
    if (ty == 0) return n;
    if (ty == 1) return ((n >> 7) << 8) + (n & 127);
    const int h = n >> 6, d = n & 63; return 256 * (h >> 2) + 128 * (d >> 5) + 32 * (h & 3) + (d & 31);
}
DI void transpose_item(const float* W, int N, int k0, int n0, bf16_t* WT, int dld, int rty, int roff, const float* kscale, LAS float* scr, int lane) {
    f32x4 v[8];
    const int kr = lane >> 3, nq = (lane & 7) * 4;
#pragma unroll
    for (int i = 0; i < 8; ++i) v[i] = *(const f32x4*)(W + (size_t)(k0 + kr + 8 * i) * N + n0 + nq);
#pragma unroll
    for (int i = 0; i < 8; ++i) { LAS float* d = scr + (kr + 8 * i) * 33 + nq; d[0] = v[i][0]; d[1] = v[i][1]; d[2] = v[i][2]; d[3] = v[i][3]; }
    asm volatile("s_waitcnt lgkmcnt(0)" ::: "memory");
    const int c = lane & 7;
    float ks[8];
#pragma unroll
    for (int i = 0; i < 8; ++i) ks[i] = kscale ? kscale[k0 + 8 * c + i] : 1.f;
#pragma unroll
    for (int j = 0; j < 4; ++j) { const int n = (lane >> 3) + 8 * j; const LAS float* s = scr + (8 * c) * 33 + n;
        u32x4 o; o.x = cvt_pk_bf16(s[0 * 33] * ks[0], s[1 * 33] * ks[1]); o.y = cvt_pk_bf16(s[2 * 33] * ks[2], s[3 * 33] * ks[3]);
        o.z = cvt_pk_bf16(s[4 * 33] * ks[4], s[5 * 33] * ks[5]); o.w = cvt_pk_bf16(s[6 * 33] * ks[6], s[7 * 33] * ks[7]);
        *(u32x4*)(WT + (size_t)(roff + rowmap(rty, n0 + n)) * dld + k0 + 8 * c) = o; }
    asm volatile("s_waitcnt lgkmcnt(0)" ::: "memory");
}
DI void transpose_job(int it, const float* W, int K, int N, bf16_t* WT, int rty, int roff, const float* kscale, LAS float* scr, int lane) {
    const int nblk = N >> 5, kb = it / nblk, nb = it - kb * nblk;
    transpose_item(W, N, kb * 64, nb * 32, WT, K, rty, roff, kscale, scr, lane);
}
DI void moe_convert_item(const Params& p, int layer, int it, LAS float* scr, int lane) {
    const int e = it / 768, r = it - e * 768;
    bf16_t* W1 = (bf16_t*)(p.ws + (layer ? WS_W1B : WS_W1)) + (size_t)e * 1024 * 1024; bf16_t* W2 = (bf16_t*)(p.ws + (layer ? WS_W2B : WS_W2)) + (size_t)e * 1024 * 512;
    const size_t eo = ((size_t)layer * 32 + e) * 1024 * 512;
    if (r < 256) transpose_job(r, p.in[I_WGATE] + eo, 1024, 512, W1, 1, 0, nullptr, scr, lane);
    else if (r < 512) transpose_job(r - 256, p.in[I_WUP] + eo, 1024, 512, W1, 1, 128, nullptr, scr, lane);
    else transpose_job(r - 512, p.in[I_WDOWN] + eo, 512, 1024, W2, 0, 0, nullptr, scr, lane);
}
constexpr int P0_SMALL = 2560 + 1024 + 784 + 128 + 288 + 64 + 64 + 512;
constexpr int P0_MOE = 32 * 768;
DI void p0_small_item(const Params& p, int it, LAS float* scr, int lane) {
    unsigned char* ws = p.ws;
    if (it < 2560) { transpose_job(it, p.in[I_ABWIN], 1024, 5120, (bf16_t*)(ws + WS_WABIN), 0, 0, nullptr, scr, lane); return; } it -= 2560;
    if (it < 1024) { transpose_job(it, p.in[I_ABWOUT], 2048, 1024, (bf16_t*)(ws + WS_WABOUT), 0, 0, nullptr, scr, lane); return; } it -= 1024;
    if (it < 784) { transpose_job(it, p.in[I_CDWIN], 1024, 1568, (bf16_t*)(ws + WS_WCDIN), 0, 0, nullptr, scr, lane); return; } it -= 784;
    if (it < 128) { transpose_job(it, p.in[I_S5WGLU], 512, 512, (bf16_t*)(ws + WS_WGLU), 0, 0, nullptr, scr, lane); return; } it -= 128;
    if (it < 288) { transpose_job(it, p.in[I_WUQ], 768, 768, (bf16_t*)(ws + WS_WUQ), 0, 0, p.in[I_QNORM], scr, lane); return; } it -= 288;
    if (it < 64) { transpose_job(it, p.in[I_WUK], 256, 512, (bf16_t*)(ws + WS_WUK), 2, 0, p.in[I_KVNORM], scr, lane); return; } it -= 64;
    if (it < 64) { transpose_job(it, p.in[I_WUV], 256, 512, (bf16_t*)(ws + WS_WUV), 0, 0, p.in[I_KVNORM], scr, lane); return; } it -= 64;
    transpose_job(it, p.in[I_CDWOUT], 1024, 1024, (bf16_t*)(ws + WS_WCDOUT), 0, 0, nullptr, scr, lane);
}
DI void sincos_red(float a, float& s, float& c) {
    const float k = rintf(a * 0.15915494309189535f);
    float r = fmaf(-k, 6.2831854820251465f, a);
    r = fmaf(-k, -1.7484555e-7f, r);
    s = __sinf(r); c = __cosf(r);
}
DI void phase_p0(const Params& p, LAS unsigned char* lds) {
    const int tid = my_tid(), lane = tid & 63, wave = __builtin_amdgcn_readfirstlane(tid >> 6), G = gridDim.x;
    LAS float* sc = (LAS float*)(lds + 8 * 16384 - 9 * 4096);
    if (blockIdx.x < 192) {
        for (int i = tid; i < 9 * 1024; i += 512) { const int r = i >> 10, k = i & 1023; const float v = r < 8 ? p.in[I_C][r * 1024 + k] : p.in[I_CCTX][k]; sc[i] = v / (1.f + expf(-v)); }
    }
    __syncthreads();
    if (blockIdx.x >= 200 && blockIdx.x < 232) s5_tables(p, lds, blockIdx.x - 200);
    if (blockIdx.x < 192) {
        const int layer = blockIdx.x / 96, n = (blockIdx.x % 96) * 64 + lane;
        const float* w = p.in[I_ADAW] + (size_t)layer * 1024 * 6144 + (size_t)(wave * 128) * 6144 + n;
        float acc[9];
#pragma unroll
        for (int r = 0; r < 9; ++r) acc[r] = 0.f;
#pragma unroll 1
        for (int k0 = 0; k0 < 128; k0 += 16) { float wv[16];
#pragma unroll
            for (int k = 0; k < 16; ++k) wv[k] = w[(size_t)(k0 + k) * 6144];
#pragma unroll
            for (int k = 0; k < 16; ++k)
#pragma unroll
                for (int r = 0; r < 9; ++r) acc[r] += sc[r * 1024 + wave * 128 + k0 + k] * wv[k]; }
        LAS float* red = (LAS float*)(lds + 69632);
#pragma unroll
        for (int r = 0; r < 9; ++r) red[(wave * 9 + r) * 64 + lane] = acc[r];
        __syncthreads();
        float* mod = (float*)(p.ws + WS_MOD);
        for (int i = tid; i < 9 * 64; i += 512) { const int r = i >> 6, c = i & 63; float sum = 0.f;
#pragma unroll
            for (int wv2 = 0; wv2 < 8; ++wv2) sum += red[(wv2 * 9 + r) * 64 + c];
            const int nn = (blockIdx.x % 96) * 64 + c;
            mod[((size_t)layer * 9 + r) * 6144 + nn] = sum + p.in[I_ADAB][layer * 6144 + nn]; }
        __syncthreads();
    }
    if (!(blockIdx.x >= 200 && blockIdx.x < 232)) {
        const int vb = blockIdx.x < 200 ? blockIdx.x : blockIdx.x - 32, NVW = (G - 32) * 8;
        LAS float* scr = (LAS float*)(lds + wave * 8704);
        for (int it = vb * 8 + wave; it < P0_SMALL + P0_MOE; it += NVW) { if (it < P0_SMALL) p0_small_item(p, it, scr, lane); else moe_convert_item(p, 0, it - P0_SMALL, scr, lane); }
    }
    {
        u32x4* z = (u32x4*)((bf16_t*)(p.ws + WS_WCDIN) + (size_t)1568 * 1024);
        const int n16 = 224 * 1024 * 2 / 16;
        for (int i = blockIdx.x * 512 + tid; i < n16; i += G * 512) z[i] = (u32x4){0u, 0u, 0u, 0u};
    }
    {
        float* wrt = (float*)(p.ws + WS_WRT);
        for (int i = blockIdx.x * 512 + tid; i < 2 * 36 * 1024; i += G * 512) { const int layer = i / 36864, r = i - layer * 36864, o = r >> 10, k = r & 1023;
            wrt[i] = o < 4 ? p.in[I_WGRP][(size_t)layer * 4096 + k * 4 + o] : p.in[I_WEXP][(size_t)layer * 32768 + k * 32 + (o - 4)]; }
    }
    if (blockIdx.x == G - 1) {
        float* rope = (float*)(p.ws + WS_ROPE);
        const int pos = tid >> 3, i = tid & 7;
        const float inv = powf(10000.f, -(float)i / 8.f);
        float s, c; sincos_red((float)pos * inv, s, c);
        rope[tid] = c; rope[512 + tid] = s;
    }
}

DI const float* resid_row_l0(const Params& p, int row) { return row < NLAT ? p.in[I_X] + (size_t)row * 1024 : p.in[I_CTX] + (size_t)(row - NLAT) * 1024; }
DI void modulate_store(const f32x4 (&v)[4], float rinv, const float* mod, int sh_off, int sc_off, bf16_t* orow, int lane) {
#pragma unroll
    for (int j = 0; j < 4; ++j) { const int c = (lane + 64 * j) * 4;
        const f32x4 sh = *(const f32x4*)(mod + sh_off + c), sc = *(const f32x4*)(mod + sc_off + c);
        const f32x4 o = v[j] * rinv * (sc + 1.f) + sh;
        u32x2 w; w.x = cvt_pk_bf16(o[0], o[1]); w.y = cvt_pk_bf16(o[2], o[3]);
        *(u32x2*)(orow + c) = w; }
}
DI void phase_p1(const Params& p) {
    const int tid_ = my_tid(); const int lane = tid_ & 63, wave = __builtin_amdgcn_readfirstlane(tid_ >> 6);
    const float* mod0 = (const float*)(p.ws + WS_MOD);
    bf16_t* Hb = (bf16_t*)(p.ws + WS_HB);
    const int NW = gridDim.x * 8;
    for (int row0 = blockIdx.x * 8 + wave; row0 < NROW; row0 += 3 * NW) {
        f32x4 v[3][4]; float ss[3];
#pragma unroll
        for (int u = 0; u < 3; ++u) { const int row = row0 + u * NW; ss[u] = 0.f;
            if (row < NROW) { const f32x4* xr = (const f32x4*)resid_row_l0(p, row) + lane;
#pragma unroll
                for (int j = 0; j < 4; ++j) v[u][j] = xr[64 * j]; } }
#pragma unroll
        for (int u = 0; u < 3; ++u) { const int row = row0 + u * NW;
            if (row < NROW) {
#pragma unroll
                for (int j = 0; j < 4; ++j) ss[u] += v[u][j][0] * v[u][j][0] + v[u][j][1] * v[u][j][1] + v[u][j][2] * v[u][j][2] + v[u][j][3] * v[u][j][3];
                const float rinv = rsqrtf(wave_sum(ss[u]) * (1.f / 1024.f) + 1e-6f);
                modulate_store(v[u], rinv, mod0 + (size_t)modrow(row) * 6144, 0, 1024, Hb + (size_t)row * 1024, lane); } }
    }
}

struct ProbABin {
    const bf16_t* Hb; const bf16_t* Wt; int G, c;
    DI bool next(int i, g8::Unit& u) const {
        const int L = i * G + c; if (L >= 72 * 20) return false;
        const int panel = L / 20, j = L - panel * 20;
        if (j < 4) { u.ty = 0; u.pm = panel; u.pn = j; } else if (j < 16) { u.ty = 1; u.pm = panel; u.pn = j - 4; } else { u.ty = 2; u.pm = j - 16; u.pn = panel; }
        u.e = 0; u.aux = 0; return true;
    }
    DI void addr(const g8::Unit& u, const int (&R)[2], const int (&C)[2], const int (&Rb)[2], g8::Addr& a) const {
        const bf16_t *A, *B;
        if (u.ty == 0) { A = Hb + (size_t)u.pm * 256 * 1024; B = Wt + (size_t)u.pn * 256 * 1024; }
        else if (u.ty == 1) { A = Hb + (size_t)u.pm * 256 * 1024; B = Wt + (size_t)(2048 + u.pn * 256) * 1024; }
        else { A = Wt + (size_t)(1024 + u.pm * 256) * 1024; B = Hb + (size_t)u.pn * 256 * 1024; }
        g8::addr_plain(a, A, 2048u, B, 2048u, 16, R, C, Rb);
    }
};
struct EpiABin {
    static constexpr bool PERM = true;
    bf16_t* Zu; bf16_t* ZB; bf16_t* GVt; float* VSS; int dry;
    DI void operator()(g8::Acc& acc, const g8::Unit& u, int wr, int wc, int fr, int fq) const {
        asm volatile("" : "+v"(fr), "+v"(fq));
        const int row0 = u.pm * 256 + wr * 64 + fr, col0 = u.pn * 256 + wc * 32 + 8 * fq;
        bf16_t* const base = u.ty == 0 ? Zu : (u.ty == 1 ? ZB : GVt);
        const size_t ld = u.ty == 0 ? 1024 : (u.ty == 1 ? 3072 : NROW);
        const bool raw = (u.ty == 1);
        float ss[2][8];
#pragma unroll
        for (int bj = 0; bj < 2; ++bj)
#pragma unroll
            for (int j = 0; j < 8; ++j) ss[bj][j] = 0.f;
#pragma unroll
        for (int ai = 0; ai < 2; ++ai)
#pragma unroll
            for (int m = 0; m < 4; ++m)
#pragma unroll
                for (int bj = 0; bj < 2; ++bj) {
                    float x[8];
#pragma unroll
                    for (int j = 0; j < 4; ++j) { x[j] = acc[ai][bj][m][0][j]; x[4 + j] = acc[ai][bj][m][1][j]; }
#pragma unroll
                    for (int j = 0; j < 8; ++j) { const float g = gelu_f(x[j]); x[j] = raw ? x[j] : g; ss[bj][j] += x[j] * x[j]; }
                    u32x4 w; w.x = cvt_pk_bf16(x[0], x[1]); w.y = cvt_pk_bf16(x[2], x[3]); w.z = cvt_pk_bf16(x[4], x[5]); w.w = cvt_pk_bf16(x[6], x[7]);
                    *(u32x4*)(base + (size_t)(row0 + ai * 128 + m * 16) * ld + col0 + bj * 128) = w;
                    __builtin_amdgcn_sched_barrier(0);
                }
        if (u.ty == 2 && !dry) {
#pragma unroll
            for (int bj = 0; bj < 2; ++bj)
#pragma unroll
                for (int j = 0; j < 8; ++j) { float s = ss[bj][j]; s += __shfl_xor(s, 1); s += __shfl_xor(s, 2); s += __shfl_xor(s, 4); s += __shfl_xor(s, 8);
                    if (fr == 0) atomicAdd(VSS + col0 + bj * 128 + j, s); }
        }
    }
};
DI void phase_p2(const Params& p, LAS unsigned char* lds, int dry = 0) {
    ProbABin P{(const bf16_t*)(p.ws + WS_HB), (const bf16_t*)(p.ws + WS_WABIN), (int)gridDim.x, (int)blockIdx.x};
    EpiABin E{(bf16_t*)(p.ws + WS_ZU), (bf16_t*)(p.ws + WS_ZB), (bf16_t*)(p.ws + WS_GVT), (float*)(p.ws + CTL_VSS), dry};
    g8::gemm_phase(lds, P, E);
}
DI void phase_p3(const Params& p, LAS unsigned char* lds) {
    const int tid = my_tid(), lane = tid & 63, wave = __builtin_amdgcn_readfirstlane(tid >> 6), fr = lane & 15, fq = lane >> 4;
    const bf16_t* Zu = (const bf16_t*)(p.ws + WS_ZU); const bf16_t* GVt = (const bf16_t*)(p.ws + WS_GVT); const bf16_t* ZB = (const bf16_t*)(p.ws + WS_ZB);
    const float* VSS = (const float*)(p.ws + CTL_VSS); bf16_t* MIX = (bf16_t*)(p.ws + WS_MIX);
    const float* sgu_norm = p.in[I_SGUNORM]; const float* sgu_w = p.in[I_SGUW]; const float* sgu_b = p.in[I_SGUB]; const float* conv_w = p.in[I_CONVW];
    for (int task = blockIdx.x * 512 + tid; task < 1024 * 128; task += gridDim.x * 512) {
        const int tb = task >> 7, ch = (task & 127) * 8, t0 = tb * 18;
        float w0[8], w1[8], w2[8];
#pragma unroll
        for (int j = 0; j < 2; ++j) { const f32x4 a = *(const f32x4*)(conv_w + ch + 4 * j), b = *(const f32x4*)(conv_w + 1024 + ch + 4 * j), c = *(const f32x4*)(conv_w + 2048 + ch + 4 * j);
#pragma unroll
            for (int e = 0; e < 4; ++e) { w0[4 * j + e] = a[e]; w1[4 * j + e] = b[e]; w2[4 * j + e] = c[e]; } }
        float prev[8], cur[8];
        {   const bf16_t* z = ZB + (size_t)t0 * 3072 + ch;
            const u32x4 c1 = *(const u32x4*)(z + 1024), x1 = *(const u32x4*)(z + 2048);
            u32x4 c0 = (u32x4){0u, 0u, 0u, 0u}, x0 = c0;
            if (t0 > 0) { c0 = *(const u32x4*)(z - 3072 + 1024); x0 = *(const u32x4*)(z - 3072 + 2048); }
#pragma unroll
            for (int j = 0; j < 4; ++j) { prev[2 * j] = bf_lo(c0[j]) * bf_lo(x0[j]); prev[2 * j + 1] = bf_hi(c0[j]) * bf_hi(x0[j]); cur[2 * j] = bf_lo(c1[j]) * bf_lo(x1[j]); cur[2 * j + 1] = bf_hi(c1[j]) * bf_hi(x1[j]); } }
#pragma unroll 1
        for (int s0 = 0; s0 < 18; s0 += 6) {
            u32x4 gb[6], cn[6], xn[6];
#pragma unroll
            for (int k = 0; k < 6; ++k) { const int t = t0 + s0 + k; const bf16_t* z = ZB + (size_t)t * 3072 + ch; gb[k] = *(const u32x4*)z;
                const bool hn = t + 1 < NROW; cn[k] = hn ? *(const u32x4*)(z + 3072 + 1024) : (u32x4){0u, 0u, 0u, 0u}; xn[k] = hn ? *(const u32x4*)(z + 3072 + 2048) : (u32x4){0u, 0u, 0u, 0u}; }
#pragma unroll
            for (int k = 0; k < 6; ++k) { const int t = t0 + s0 + k;
                const int l = t < NLAT ? (t & 2047) : ((t - NLAT) & 255), len = t < NLAT ? 2048 : 256;
                const float mp = l > 0 ? 1.f : 0.f, mn = l < len - 1 ? 1.f : 0.f;
                float nx[8]; unsigned o[4];
#pragma unroll
                for (int j = 0; j < 4; ++j) { nx[2 * j] = bf_lo(cn[k][j]) * bf_lo(xn[k][j]); nx[2 * j + 1] = bf_hi(cn[k][j]) * bf_hi(xn[k][j]); }
#pragma unroll
                for (int j = 0; j < 4; ++j) {
                    const float lo = bf_lo(gb[k][j]) * (w0[2 * j] * prev[2 * j] * mp + w1[2 * j] * cur[2 * j] + w2[2 * j] * nx[2 * j] * mn);
                    const float hi = bf_hi(gb[k][j]) * (w0[2 * j + 1] * prev[2 * j + 1] * mp + w1[2 * j + 1] * cur[2 * j + 1] + w2[2 * j + 1] * nx[2 * j + 1] * mn);
                    o[j] = cvt_pk_bf16(lo, hi); }
                *(u32x4*)(MIX + (size_t)t * 2048 + 1024 + ch) = (u32x4){o[0], o[1], o[2], o[3]};
#pragma unroll
                for (int j = 0; j < 8; ++j) { prev[j] = cur[j]; cur[j] = nx[j]; }
            }
        }
    }
    LAS unsigned char* Wl = lds; LAS unsigned char* Vl = lds + 34816;
    const int g = blockIdx.x & 7, ch0 = g * 128;
    const int pp_w = tid >> 2, part = tid & 3;
    f32x4 wreg[8];
    {   const f32x4* src = (const f32x4*)(sgu_w + ((size_t)g * 128 + pp_w) * 128 + part * 32);
#pragma unroll
        for (int i = 0; i < 8; ++i) wreg[i] = src[i]; }
    const int nit = (144 * 8 - (int)blockIdx.x + (int)gridDim.x - 1) / (int)gridDim.x;
    u32x4 vreg[4]; f32x4 rvr[8];
    auto prefetch = [&](int it) { const int c = (it * (int)gridDim.x + (int)blockIdx.x) >> 3, t0 = c * 128;
        const u32x4* src = (const u32x4*)(GVt + (size_t)(ch0 + pp_w) * NROW + t0 + part * 32);
#pragma unroll
        for (int i = 0; i < 4; ++i) vreg[i] = src[i];
#pragma unroll
        for (int i = 0; i < 8; ++i) rvr[i] = *(const f32x4*)(VSS + t0 + part * 32 + 4 * i); };
    if (nit > 0) prefetch(0);
    for (int it = 0; it < nit; ++it) {
        const int c = (it * (int)gridDim.x + (int)blockIdx.x) >> 3, t0 = c * 128;
        __syncthreads();
#pragma unroll
        for (int i = 0; i < 4; ++i) *(LAS u32x4*)(Vl + pp_w * 272 + part * 64 + i * 16) = vreg[i];
#pragma unroll
        for (int i = 0; i < 4; ++i) { const f32x4 a = wreg[2 * i], b = wreg[2 * i + 1]; f32x4 r0 = rvr[2 * i], r1 = rvr[2 * i + 1];
#pragma unroll
            for (int e = 0; e < 4; ++e) { r0[e] = rsqrtf(r0[e] * (1.f / 1024.f) + 1e-6f); r1[e] = rsqrtf(r1[e] * (1.f / 1024.f) + 1e-6f); }
            u32x4 w; w.x = cvt_pk_bf16(a[0] * r0[0], a[1] * r0[1]); w.y = cvt_pk_bf16(a[2] * r0[2], a[3] * r0[3]); w.z = cvt_pk_bf16(b[0] * r1[0], b[1] * r1[1]); w.w = cvt_pk_bf16(b[2] * r1[2], b[3] * r1[3]);
            *(LAS u32x4*)(Wl + pp_w * 272 + part * 64 + i * 16) = w; }
        __syncthreads();
        if (it + 1 < nit) prefetch(it + 1);
        const int pp = wave * 16 + fr, tok = t0 + pp;
        u32x2 gu[8];
#pragma unroll
        for (int n = 0; n < 8; ++n) gu[n] = *(const u32x2*)(Zu + (size_t)tok * 1024 + ch0 + n * 16 + 4 * fq);
        f32x4 acc[8];
#pragma unroll
        for (int n = 0; n < 8; ++n) acc[n] = (f32x4){0.f, 0.f, 0.f, 0.f};
#pragma unroll
        for (int ks = 0; ks < 4; ++ks) {
            const bf16x8 wf = *(const LAS bf16x8*)(Wl + (wave * 16 + fr) * 272 + ks * 64 + fq * 16);
#pragma unroll
            for (int n = 0; n < 8; ++n) { const bf16x8 vf = *(const LAS bf16x8*)(Vl + (n * 16 + fr) * 272 + ks * 64 + fq * 16);
                acc[n] = __builtin_amdgcn_mfma_f32_16x16x32_bf16(vf, wf, acc[n], 0, 0, 0); }
        }
        const float bb = sgu_b[g * 128 + pp];
#pragma unroll
        for (int n = 0; n < 8; ++n) { const int ch = ch0 + n * 16 + 4 * fq;
            const f32x4 nm = *(const f32x4*)(sgu_norm + ch);
            const float y0 = bf_lo(gu[n].x) * (acc[n][0] * nm[0] + bb), y1 = bf_hi(gu[n].x) * (acc[n][1] * nm[1] + bb), y2 = bf_lo(gu[n].y) * (acc[n][2] * nm[2] + bb), y3 = bf_hi(gu[n].y) * (acc[n][3] * nm[3] + bb);
            u32x2 w; w.x = cvt_pk_bf16(y0, y1); w.y = cvt_pk_bf16(y2, y3);
            *(u32x2*)(MIX + (size_t)tok * 2048 + ch) = w; }
    }
}

struct ProbPlain {
    const void* A; const void* B; unsigned sA, sB; int nM, nN, nt, G, c;
    DI bool next(int i, g8::Unit& u) const { const int L = i * G + c; if (L >= nM * nN) return false; u.ty = 0; u.pm = L / nN; u.pn = L - u.pm * nN; u.e = 0; u.aux = 0; return true; }
    DI void addr(const g8::Unit& u, const int (&R)[2], const int (&C)[2], const int (&Rb)[2], g8::Addr& a) const {
        g8::addr_plain(a, (const char*)A + (size_t)u.pm * 256 * sA, sA, (const char*)B + (size_t)u.pn * 256 * sB, sB, nt, R, C, Rb);
    }
};
struct EpiResid {
    static constexpr bool PERM = false;
    const float* xin_lat; const float* xin_ctx; float* xout_lat; float* xout_ctx; const float* gate; float* SS; int dry;
    DI void operator()(g8::Acc& acc, const g8::Unit& u, int wr, int wc, int fr, int fq) const {
        asm volatile("" : "+v"(fr), "+v"(fq));
        const int rowt = u.pm * 256; const bool lat = rowt < NLAT;
        const float* xin = lat ? xin_lat + (size_t)rowt * 1024 : xin_ctx + (size_t)(rowt - NLAT) * 1024;
        float* xout = lat ? xout_lat + (size_t)rowt * 1024 : xout_ctx + (size_t)(rowt - NLAT) * 1024;
        const float* gt = gate + (size_t)modrow(rowt) * 6144;
        const int col0 = u.pn * 256 + wc * 32 + 4 * fq;
        f32x4 gv[2][2];
#pragma unroll
        for (int bj = 0; bj < 2; ++bj)
#pragma unroll
            for (int n = 0; n < 2; ++n) gv[bj][n] = *(const f32x4*)(gt + col0 + bj * 128 + n * 16);
#pragma unroll
        for (int ai = 0; ai < 2; ++ai)
#pragma unroll
            for (int m = 0; m < 4; ++m) {
                const int rl = ai * 128 + wr * 64 + m * 16 + fr; const size_t ro = (size_t)rl * 1024 + col0;
                float ss = 0.f;
#pragma unroll
                for (int bj = 0; bj < 2; ++bj)
#pragma unroll
                    for (int n = 0; n < 2; ++n) { const f32x4 xi = *(const f32x4*)(xin + ro + bj * 128 + n * 16); const f32x4 o = xi + gv[bj][n] * acc[ai][bj][m][n];
                        *(f32x4*)(xout + ro + bj * 128 + n * 16) = o; ss += o[0] * o[0] + o[1] * o[1] + o[2] * o[2] + o[3] * o[3]; }
                ss += __shfl_xor(ss, 16); ss += __shfl_xor(ss, 32);
                if (fq == 0 && !dry) atomicAdd(SS + rowt + rl, ss);
                __builtin_amdgcn_sched_barrier(0);
            }
    }
};
constexpr int P4_CONV = 12288;
DI void phase_p4(const Params& p, LAS unsigned char* lds, int dry = 0) {
    ProbPlain P{p.ws + WS_MIX, p.ws + WS_WABOUT, 4096u, 4096u, 72, 4, 32, (int)gridDim.x, (int)blockIdx.x};
    EpiResid E{p.in[I_X], p.in[I_CTX], p.out, (float*)(p.ws + WS_XC), (const float*)(p.ws + WS_MOD) + 2048, (float*)(p.ws + CTL_SS1), dry};
    g8::gemm_phase(lds, P, E);
    const int idle0 = 72 * 4 - (int)gridDim.x;
    if ((int)blockIdx.x >= idle0 && !dry) {
        const int tid = my_tid(), lane = tid & 63, wave = __builtin_amdgcn_readfirstlane(tid >> 6);
        LAS float* scr = (LAS float*)(lds + wave * 8704);
        const int nw = ((int)gridDim.x - idle0) * 8;
        for (int it = ((int)blockIdx.x - idle0) * 8 + wave; it < P4_CONV; it += nw) moe_convert_item(p, 1, it, scr, lane);
    }
}
constexpr int LDS_MISC = 147456;
DI float* resid_row(const Params& p, int row) { return row < NLAT ? p.out + (size_t)row * 1024 : (float*)(p.ws + WS_XC) + (size_t)(row - NLAT) * 1024; }

template <int LAYER> DI void phase_router(const Params& p, LAS unsigned char* lds, int dry = 0) {
    constexpr int NR = LAYER == 0 ? NROW : NLAT;
    const int tid = my_tid(), lane = tid & 63, wave = __builtin_amdgcn_readfirstlane(tid >> 6);
    LAS float* W = (LAS float*)lds;
    {   const f32x4* src = (const f32x4*)((const float*)(p.ws + WS_WRT) + (size_t)LAYER * 36 * 1024);
        for (int i = tid; i < 36 * 256; i += 512) *(LAS f32x4*)(W + i * 4) = src[i]; }
    __syncthreads();
    const float* mod = (const float*)(p.ws + WS_MOD) + (size_t)LAYER * 9 * 6144;
    const float* SS = (const float*)(p.ws + (LAYER == 0 ? CTL_SS1 : CTL_SS2));
    const float* bg = p.in[I_BGRP] + LAYER * 4; const float* be = p.in[I_BEXP] + LAYER * 32;
    unsigned* cnt = (unsigned*)(p.ws + CTL_CNT) + LAYER * 32 * 64;
    int* ROUTE = (int*)(p.ws + (dry ? WS_MOEEND : WS_ROUTE)); float* RWT = (float*)(p.ws + (dry ? WS_MOEEND + (8u << 20) : WS_RWT)); int* LIST = (int*)(p.ws + (dry ? WS_MOEEND + (16u << 20) : WS_LIST));
    bf16_t* Hb = (bf16_t*)(p.ws + WS_HB);
    if (dry) cnt = (unsigned*)(p.ws + WS_MOEEND + (32u << 20));
    const int half = lane >> 5, ex = lane & 31;
    for (int row0 = (blockIdx.x * 8 + wave) * 2; row0 < NR; row0 += gridDim.x * 16) {
        f32x4 t[2][4];
#pragma unroll
        for (int rr = 0; rr < 2; ++rr) { const int row = row0 + rr;
            const f32x4* xr = (const f32x4*)resid_row(p, row) + lane;
            const float* m = mod + (size_t)modrow(row) * 6144;
            const float rinv = rsqrtf(SS[row] * (1.f / 1024.f) + 1e-6f);
#pragma unroll
            for (int j = 0; j < 4; ++j) { const int c = (lane + 64 * j) * 4; const f32x4 sh = *(const f32x4*)(m + 3072 + c), sc = *(const f32x4*)(m + 4096 + c);
                t[rr][j] = xr[64 * j] * rinv * (sc + 1.f) + sh;
                u32x2 w; w.x = cvt_pk_bf16(t[rr][j][0], t[rr][j][1]); w.y = cvt_pk_bf16(t[rr][j][2], t[rr][j][3]);
                *(u32x2*)(Hb + (size_t)row * 1024 + c) = w; } }
        float gq[4], v[64];
#pragma unroll
        for (int o = 0; o < 36; ++o) { float a0 = 0.f, a1 = 0.f;
#pragma unroll
            for (int j = 0; j < 4; ++j) { const f32x4 w = *(const LAS f32x4*)(W + o * 1024 + (lane + 64 * j) * 4);
                a0 += t[0][j][0] * w[0] + t[0][j][1] * w[1] + t[0][j][2] * w[2] + t[0][j][3] * w[3]; a1 += t[1][j][0] * w[0] + t[1][j][1] * w[1] + t[1][j][2] * w[2] + t[1][j][3] * w[3]; }
            if (o < 4) { const float send = half ? a0 : a1, keep = half ? a1 : a0; gq[o] = keep + __shfl_xor(send, 32); }
            else { v[o - 4] = a0; v[32 + o - 4] = a1; }
            if ((o & 7) == 7) __builtin_amdgcn_sched_barrier(0);
        }
#pragma unroll
        for (int o = 0; o < 4; ++o) { float g = gq[o]; g += __shfl_xor(g, 16); g += __shfl_xor(g, 8); g += __shfl_xor(g, 4); g += __shfl_xor(g, 2); g += __shfl_xor(g, 1); gq[o] = g; }
#define RT_STAGE(n, msk) { const bool up = (lane & (msk)) != 0; _Pragma("unroll") for (int i = 0; i < (n) / 2; ++i) { const float lo_ = v[i], hi_ = v[i + (n) / 2]; v[i] = (up ? hi_ : lo_) + __shfl_xor(up ? lo_ : hi_, (msk)); } }
        RT_STAGE(64, 32) RT_STAGE(32, 16) RT_STAGE(16, 8) RT_STAGE(8, 4) RT_STAGE(4, 2) RT_STAGE(2, 1)
#undef RT_STAGE
        const int row = row0 + half;
        int grp = 0; float mx = gq[0] + bg[0];
        float gl[4];
#pragma unroll
        for (int i = 0; i < 4; ++i) gl[i] = gq[i] + bg[i];
#pragma unroll
        for (int i = 1; i < 4; ++i) if (gl[i] > mx) { mx = gl[i]; grp = i; }
        float den = 0.f;
#pragma unroll
        for (int i = 0; i < 4; ++i) den += expf(gl[i] - mx);
        const float ptop = 1.f / den;
        const float el = v[0] + be[ex]; const bool valid = (ex >> 3) == grp;
        float m1 = valid ? el : -3.0e38f;
#pragma unroll
        for (int o = 1; o < 32; o <<= 1) m1 = fmaxf(m1, __shfl_xor(m1, o));
        const unsigned long long b1 = __ballot(valid && el == m1);
        const int i0 = __builtin_ctz((unsigned)(b1 >> (32 * half)));
        float m2 = (valid && ex != i0) ? el : -3.0e38f;
#pragma unroll
        for (int o = 1; o < 32; o <<= 1) m2 = fmaxf(m2, __shfl_xor(m2, o));
        const unsigned long long b2 = __ballot(valid && ex != i0 && el == m2);
        const int i1 = __builtin_ctz((unsigned)(b2 >> (32 * half)));
        const float exx = expf(m2 - m1);
        const float w0 = ptop / (1.f + exx), w1 = ptop * exx / (1.f + exx);
        if (ex == 0) {
            const int ea = i0, eb = i1;
            const int pa = (int)__hip_atomic_fetch_add(cnt + ea * 64, 1u, __ATOMIC_RELAXED, __HIP_MEMORY_SCOPE_AGENT);
            const int pb = (int)__hip_atomic_fetch_add(cnt + eb * 64, 1u, __ATOMIC_RELAXED, __HIP_MEMORY_SCOPE_AGENT);
            *(int4*)(ROUTE + (size_t)row * 4) = make_int4(ea, pa, eb, pb);
            *(float2*)(RWT + (size_t)row * 2) = make_float2(w0, w1);
            LIST[(size_t)ea * NROW + (dry ? 0 : pa)] = row; LIST[(size_t)eb * NROW + (dry ? 1 : pb)] = row;
        }
    }
}
DI void moe_tables(const Params& p, int layer, LAS unsigned char* lds) {
    LAS int* tb = (LAS int*)(lds + LDS_MISC + 64);
    const unsigned* cnt = (const unsigned*)(p.ws + CTL_CNT) + layer * 32 * 64;
    if (threadIdx.x < 32) tb[threadIdx.x] = (int)cnt[threadIdx.x * 64];
    __syncthreads();
    if (threadIdx.x == 0) { int a = 0; for (int e = 0; e < 32; ++e) { tb[32 + e] = a; a += (tb[e] + 255) >> 8; } tb[64] = a; }
    __syncthreads();
}
struct ProbMoe {
    const bf16_t* A; const bf16_t* W; const int* LIST; LAS const int* tb; int gather; unsigned sA, sB; int nt, G, c; size_t wstride;
    DI bool next(int i, g8::Unit& u) const {
        const int L = i * G + c; if (L >= tb[64] * 4) return false;
        const int tile = L >> 2; int e = 0;
        for (int k = 1; k < 32; ++k) e = (tb[32 + k] <= tile) ? k : e;
        u.ty = 0; u.e = e; u.pm = tile - tb[32 + e]; u.pn = L & 3; u.aux = tb[32 + e] * 256; return true;
    }
    DI void addr(const g8::Unit& u, const int (&R)[2], const int (&C)[2], const int (&Rb)[2], g8::Addr& a) const {
        const char* Bb = (const char*)(W + (size_t)u.e * wstride) + (size_t)u.pn * 256 * sB;
        if (gather) {
            g8::addr_plain(a, A, sA, Bb, sB, nt, R, C, Rb);
            const int n = tb[u.e]; const int* lst = LIST + (size_t)u.e * NROW;
#pragma unroll
            for (int h = 0; h < 2; ++h)
#pragma unroll
                for (int i = 0; i < 2; ++i) { const int pos = u.pm * 256 + h * 128 + R[i]; const int tok = lst[pos < n ? pos : 0]; a.vA[h][i] = (unsigned)tok * sA + (unsigned)C[i] * 2u; }
        } else {
            g8::addr_plain(a, (const char*)A + (size_t)(u.aux + u.pm * 256) * sA, sA, Bb, sB, nt, R, C, Rb);
        }
    }
};
struct EpiMoe1 {
    static constexpr bool PERM = true;
    bf16_t* Hid;
    DI void operator()(g8::Acc& acc, const g8::Unit& u, int wr, int wc, int fr, int fq) const {
        asm volatile("" : "+v"(fr), "+v"(fq));
        const int row0 = u.aux + u.pm * 256 + wr * 64 + fr, col0 = u.pn * 128 + wc * 32 + 8 * fq;
#pragma unroll
        for (int ai = 0; ai < 2; ++ai)
#pragma unroll
            for (int m = 0; m < 4; ++m) {
                float x[8];
#pragma unroll
                for (int j = 0; j < 4; ++j) { x[j] = silu_f(acc[ai][0][m][0][j]) * acc[ai][1][m][0][j]; x[4 + j] = silu_f(acc[ai][0][m][1][j]) * acc[ai][1][m][1][j]; }
                u32x4 w; w.x = cvt_pk_bf16(x[0], x[1]); w.y = cvt_pk_bf16(x[2], x[3]); w.z = cvt_pk_bf16(x[4], x[5]); w.w = cvt_pk_bf16(x[6], x[7]);
                *(u32x4*)(Hid + (size_t)(row0 + ai * 128 + m * 16) * 512 + col0) = w;
                __builtin_amdgcn_sched_barrier(0);
            }
    }
};
struct EpiMoe2 {
    static constexpr bool PERM = true;
    bf16_t* Ys;
    DI void operator()(g8::Acc& acc, const g8::Unit& u, int wr, int wc, int fr, int fq) const {
        asm volatile("" : "+v"(fr), "+v"(fq));
        const int row0 = u.aux + u.pm * 256 + wr * 64 + fr, col0 = u.pn * 256 + wc * 32 + 8 * fq;
#pragma unroll
        for (int ai = 0; ai < 2; ++ai)
#pragma unroll
            for (int m = 0; m < 4; ++m)
#pragma unroll
                for (int bj = 0; bj < 2; ++bj) g8::store8<0>(Ys + (size_t)(row0 + ai * 128 + m * 16) * 1024 + col0 + bj * 128, acc[ai][bj][m][0], acc[ai][bj][m][1]);
    }
};
template <int LAYER> DI void phase_moe1(const Params& p, LAS unsigned char* lds) {
    moe_tables(p, LAYER, lds);
    ProbMoe P{(const bf16_t*)(p.ws + WS_HB), (const bf16_t*)(p.ws + (LAYER ? WS_W1B : WS_W1)), (const int*)(p.ws + WS_LIST), (LAS const int*)(lds + LDS_MISC + 64), 1, 2048u, 2048u, 16, (int)gridDim.x, (int)blockIdx.x, (size_t)1024 * 1024};
    EpiMoe1 E{(bf16_t*)(p.ws + WS_HID)};
    g8::gemm_phase(lds, P, E);
}
template <int LAYER> DI void phase_moe2(const Params& p, LAS unsigned char* lds) {
    moe_tables(p, LAYER, lds);
    ProbMoe P{(const bf16_t*)(p.ws + WS_HID), (const bf16_t*)(p.ws + (LAYER ? WS_W2B : WS_W2)), nullptr, (LAS const int*)(lds + LDS_MISC + 64), 0, 1024u, 1024u, 8, (int)gridDim.x, (int)blockIdx.x, (size_t)1024 * 512};
    EpiMoe2 E{(bf16_t*)(p.ws + WS_YS)};
    g8::gemm_phase(lds, P, E);
}
template <int LAYER> DI void phase_combine(const Params& p, LAS unsigned char* lds, int dry = 0) {
    constexpr int NR = LAYER == 0 ? NROW : NLAT;
    moe_tables(p, LAYER, lds);
    LAS const int* tb = (LAS const int*)(lds + LDS_MISC + 64);
    const int tid_ = my_tid(); const int lane = tid_ & 63, wave = __builtin_amdgcn_readfirstlane(tid_ >> 6);
    const float* mod = (const float*)(p.ws + WS_MOD) + (size_t)LAYER * 9 * 6144;
    const int* ROUTE = (const int*)(p.ws + WS_ROUTE); const float* RWT = (const float*)(p.ws + WS_RWT);
    const bf16_t* Ys = (const bf16_t*)(p.ws + WS_YS); bf16_t* Hb = (bf16_t*)(p.ws + WS_HB);
    const int NW = gridDim.x * 8;
    for (int row0 = blockIdx.x * 8 + wave; row0 < NR; row0 += 2 * NW) {
        int4 rt[2]; float2 wt[2];
#pragma unroll
        for (int u = 0; u < 2; ++u) { const int row = row0 + u * NW < NR ? row0 + u * NW : row0; rt[u] = *(const int4*)(ROUTE + (size_t)row * 4); wt[u] = *(const float2*)(RWT + (size_t)row * 2); }
        u32x2 ya[2][4], yb[2][4]; f32x4 xv[2][4];
#pragma unroll
        for (int u = 0; u < 2; ++u) { const int row = row0 + u * NW < NR ? row0 + u * NW : row0;
            const bf16_t* y0 = Ys + (size_t)(tb[32 + rt[u].x] * 256 + rt[u].y) * 1024; const bf16_t* y1 = Ys + (size_t)(tb[32 + rt[u].z] * 256 + rt[u].w) * 1024;
            const float* xr = resid_row(p, row);
#pragma unroll
            for (int j = 0; j < 4; ++j) { const int c = (lane + 64 * j) * 4; ya[u][j] = *(const u32x2*)(y0 + c); yb[u][j] = *(const u32x2*)(y1 + c); xv[u][j] = *(const f32x4*)(xr + c); } }
#pragma unroll
        for (int u = 0; u < 2; ++u) { const int row = row0 + u * NW;
            if (row < NR) {
                float* xr = resid_row(p, row);
                float* xw = dry ? (float*)(p.ws + WS_MOEEND) + (size_t)(row & 8191) * 1024 : xr;
                const float* m = mod + (size_t)modrow(row) * 6144;
                f32x4 v[4]; float ss = 0.f;
#pragma unroll
                for (int j = 0; j < 4; ++j) { const int c = (lane + 64 * j) * 4;
                    const u32x2 a = ya[u][j], b2 = yb[u][j]; const f32x4 g = *(const f32x4*)(m + 5120 + c);
                    f32x4 y; y[0] = wt[u].x * bf_lo(a.x) + wt[u].y * bf_lo(b2.x); y[1] = wt[u].x * bf_hi(a.x) + wt[u].y * bf_hi(b2.x); y[2] = wt[u].x * bf_lo(a.y) + wt[u].y * bf_lo(b2.y); y[3] = wt[u].x * bf_hi(a.y) + wt[u].y * bf_hi(b2.y);
                    v[j] = xv[u][j] + g * y;
                    *(f32x4*)(xw + c) = v[j];
                    ss += v[j][0] * v[j][0] + v[j][1] * v[j][1] + v[j][2] * v[j][2] + v[j][3] * v[j][3]; }
                if (LAYER == 0) {
                    const float rinv = rsqrtf(wave_sum(ss) * (1.f / 1024.f) + 1e-6f);
                    modulate_store(v, rinv, m + 9 * 6144, 0, 1024, (dry ? (bf16_t*)(p.ws + WS_MOEEND + (64u << 20)) + (size_t)(row & 8191) * 1024 : Hb + (size_t)row * 1024), lane);
                }
            }
        }
    }
    if (LAYER == 0) {
        __syncthreads();
        LAS float* scr = (LAS float*)(lds + wave * 8704);
        for (int it = P4_CONV + blockIdx.x * 8 + wave; it < P0_MOE; it += gridDim.x * 8) moe_convert_item(p, 1, it, scr, lane);
    }
}
typedef __bf16 bf16v2 __attribute__((ext_vector_type(2)));
DI unsigned pk_bf16(float lo, float hi) { f32x2 v = {lo, hi}; bf16v2 b = __builtin_convertvector(v, bf16v2); return __builtin_bit_cast(unsigned, b); }

struct ProbCDin {
    const bf16_t* Hb; const bf16_t* Wt; int G, c;
    DI bool next(int i, g8::Unit& u) const {
        const int L = i * G + c; if (L >= 448 + 32) return false;
        if (L < 448) { u.pm = L / 7; u.pn = L - u.pm * 7; } else { const int r = L - 448; u.pm = 64 + (r >> 2); const int q = r & 3; u.pn = q < 2 ? q : q + 3; }
        u.ty = 0; u.e = 0; u.aux = 0; return true;
    }
    DI void addr(const g8::Unit& u, const int (&R)[2], const int (&C)[2], const int (&Rb)[2], g8::Addr& a) const {
        g8::addr_plain(a, Hb + (size_t)u.pm * 256 * 1024, 2048u, Wt + (size_t)u.pn * 256 * 1024, 2048u, 16, R, C, Rb);
    }
};
struct EpiCDin {
    static constexpr bool PERM = true;
    bf16_t* UC; bf16_t* ZZ; float* SSQ; float* SSKV; int dry;
    DI void operator()(g8::Acc& acc, const g8::Unit& u, int wr, int wc, int fr, int fq) const {
        asm volatile("" : "+v"(fr), "+v"(fq));
        const int row0 = u.pm * 256 + wr * 64 + fr, colw = u.pn * 256 + wc * 32 + 8 * fq;
        const bool isu = u.pn < 2;
        float* const SS = u.pn == 5 ? SSKV : SSQ; const bool stat = (u.pn >= 2 && u.pn <= 5);
#pragma unroll
        for (int ai = 0; ai < 2; ++ai)
#pragma unroll
            for (int m = 0; m < 4; ++m) {
                const int row = row0 + ai * 128 + m * 16; float ss = 0.f;
#pragma unroll
                for (int bj = 0; bj < 2; ++bj) { const int col = colw + bj * 128;
                    bf16_t* du = UC + ((size_t)(col >> 4) * 1280 + (row >> 4)) * 512 + (row & 15) * 16 + (col & 15);
                    bf16_t* dz = ZZ + (size_t)row * 1280 + (col - 512);
                    g8::store8<0>(isu ? du : dz, acc[ai][bj][m][0], acc[ai][bj][m][1]);
#pragma unroll
                    for (int j = 0; j < 4; ++j) ss += acc[ai][bj][m][0][j] * acc[ai][bj][m][0][j] + acc[ai][bj][m][1][j] * acc[ai][bj][m][1][j]; }
                ss += __shfl_xor(ss, 16); ss += __shfl_xor(ss, 32);
                if (stat && fq == 0 && !dry) atomicAdd(SS + row, ss);
                __builtin_amdgcn_sched_barrier(0);
            }
    }
};
DI void phase_cdin(const Params& p, LAS unsigned char* lds, int dry = 0) {
    ProbCDin P{(const bf16_t*)(p.ws + WS_HB), (const bf16_t*)(p.ws + WS_WCDIN), (int)gridDim.x, (int)blockIdx.x};
    EpiCDin E{(bf16_t*)(p.ws + WS_UC), (bf16_t*)(p.ws + WS_ZZ), (float*)(p.ws + CTL_SSQ), (float*)(p.ws + CTL_SSKV), dry};
    g8::gemm_phase(lds, P, E);
}

struct ProbS5 {
    const bf16_t* UC; const bf16_t* W; int nPm, nt; unsigned sB; size_t wstride; int G, c;
    DI bool next(int i, g8::Unit& u) const { const int L = i * G + c; if (L >= 32 * nPm) return false; u.e = L / nPm; u.pm = L - u.e * nPm; u.pn = 0; u.ty = 0; u.aux = 0; return true; }
    DI void addr(const g8::Unit& u, const int (&R)[2], const int (&C)[2], const int (&Rb)[2], g8::Addr& a) const {
        g8::addr_plain(a, UC + ((size_t)u.e * 1280 + u.pm * 256) * 512, 1024u, W + (size_t)u.e * wstride, sB, nt, R, C, Rb);
    }
};
struct EpiSend {
    static constexpr bool PERM = false;
    float* S;
    DI void operator()(g8::Acc& acc, const g8::Unit& u, int wr, int wc, int fr, int fq) const {
        asm volatile("" : "+v"(fr), "+v"(fq));
        float* base = S + ((size_t)u.e * 1280 + u.pm * 256 + wr * 64 + fr) * 256 + wc * 32 + 4 * fq;
#pragma unroll
        for (int ai = 0; ai < 2; ++ai)
#pragma unroll
            for (int m = 0; m < 4; ++m)
#pragma unroll
                for (int bj = 0; bj < 2; ++bj)
#pragma unroll
                    for (int n = 0; n < 2; ++n) *(f32x4*)(base + (size_t)(ai * 128 + m * 16) * 256 + bj * 128 + n * 16) = acc[ai][bj][m][n];
    }
};
struct EpiQ {
    static constexpr bool PERM = true;
    bf16_t* Q; const float* SSQ; float* HSS; const float* gain; const float* rope; int dry;
    DI void operator()(g8::Acc& acc, const g8::Unit& u, int wr, int wc, int fr, int fq) const {
        asm volatile("" : "+v"(fr), "+v"(fq));
        const int row0 = u.pm * 256 + wr * 64 + fr;
        float gn[2][8]; int head[2]; bool rp[2];
#pragma unroll
        for (int bj = 0; bj < 2; ++bj) { const int grp = u.pn * 8 + bj * 4 + wc; head[bj] = grp / 3; const int part = grp - head[bj] * 3; rp[bj] = (part == 2);
#pragma unroll
            for (int j = 0; j < 8; ++j) gn[bj][j] = gain[part * 32 + 8 * fq + j]; }
        const float sgn = (fq & 1) ? 1.f : -1.f;
#pragma unroll
        for (int ai = 0; ai < 2; ++ai)
#pragma unroll
            for (int m = 0; m < 4; ++m) {
                const int row = row0 + ai * 128 + m * 16, l = row & 2047, pos = fq < 2 ? (l >> 6) : (l & 63);
                const float rq = rsqrtf(SSQ[row] * (1.f / 768.f) + 1e-6f);
                const f32x4 c0 = *(const f32x4*)(rope + pos * 8), c1 = *(const f32x4*)(rope + pos * 8 + 4), s0 = *(const f32x4*)(rope + 512 + pos * 8), s1 = *(const f32x4*)(rope + 512 + pos * 8 + 4);
                const float cs[8] = {c0[0], c0[1], c0[2], c0[3], c1[0], c1[1], c1[2], c1[3]}, sn[8] = {s0[0], s0[1], s0[2], s0[3], s1[0], s1[1], s1[2], s1[3]};
#pragma unroll
                for (int bj = 0; bj < 2; ++bj) {
                    float x[8], ss = 0.f;
#pragma unroll
                    for (int j = 0; j < 4; ++j) { x[j] = acc[ai][bj][m][0][j] * rq; x[4 + j] = acc[ai][bj][m][1][j] * rq; }
#pragma unroll
                    for (int j = 0; j < 8; ++j) { ss += x[j] * x[j]; x[j] *= gn[bj][j]; }
                    ss += __shfl_xor(ss, 16); ss += __shfl_xor(ss, 32);
                    if (fq == 0 && !dry) atomicAdd(HSS + (size_t)row * 8 + head[bj], ss);
#pragma unroll
                    for (int j = 0; j < 8; ++j) { const float pr = __shfl_xor(x[j], 16); const float cc = rp[bj] ? cs[j] : 1.f, sv = rp[bj] ? sgn * sn[j] : 0.f; x[j] = x[j] * cc + pr * sv; }
                    u32x4 w; w.x = cvt_pk_bf16(x[0], x[1]); w.y = cvt_pk_bf16(x[2], x[3]); w.z = cvt_pk_bf16(x[4], x[5]); w.w = cvt_pk_bf16(x[6], x[7]);
                    *(u32x4*)(Q + (size_t)row * 768 + u.pn * 256 + bj * 128 + wc * 32 + 8 * fq) = w;
                }
                __builtin_amdgcn_sched_barrier(0);
            }
    }
};
struct EpiK {
    static constexpr bool PERM = true;
    bf16_t* K; const bf16_t* ZZ; const float* SSKV; const float* gain; const float* rope;
    DI void operator()(g8::Acc& acc, const g8::Unit& u, int wr, int wc, int fr, int fq) const {
        asm volatile("" : "+v"(fr), "+v"(fq));
        const int row0 = u.pm * 256 + wr * 64 + fr, head = u.pn * 4 + wc;
        float gn[2][8], gr[8], gp[8];
#pragma unroll
        for (int j = 0; j < 8; ++j) { gn[0][j] = gain[8 * fq + j]; gn[1][j] = gain[32 + 8 * fq + j]; gr[j] = gain[64 + 8 * fq + j]; gp[j] = gain[64 + 8 * (fq ^ 1) + j]; }
        const float sgn = (fq & 1) ? 1.f : -1.f;
#pragma unroll
        for (int ai = 0; ai < 2; ++ai)
#pragma unroll
            for (int m = 0; m < 4; ++m) {
                const int row = row0 + ai * 128 + m * 16; const bool lat = row < NLAT; const int l = row & 2047, pos = fq < 2 ? (l >> 6) : (l & 63);
                const float rkv = rsqrtf(SSKV[row] * (1.f / 256.f) + 1e-6f);
                const u32x4 ko = *(const u32x4*)(ZZ + (size_t)row * 1280 + 1024 + 8 * fq), kp = *(const u32x4*)(ZZ + (size_t)row * 1280 + 1024 + 8 * (fq ^ 1));
                float xo[8] = {bf_lo(ko.x), bf_hi(ko.x), bf_lo(ko.y), bf_hi(ko.y), bf_lo(ko.z), bf_hi(ko.z), bf_lo(ko.w), bf_hi(ko.w)};
                const float xp[8] = {bf_lo(kp.x), bf_hi(kp.x), bf_lo(kp.y), bf_hi(kp.y), bf_lo(kp.z), bf_hi(kp.z), bf_lo(kp.w), bf_hi(kp.w)};
                float ss = 0.f;
#pragma unroll
                for (int j = 0; j < 8; ++j) ss += xo[j] * xo[j];
                float xn[2][8];
#pragma unroll
                for (int bj = 0; bj < 2; ++bj)
#pragma unroll
                    for (int j = 0; j < 4; ++j) { xn[bj][j] = acc[ai][bj][m][0][j] * rkv; xn[bj][4 + j] = acc[ai][bj][m][1][j] * rkv; }
#pragma unroll
                for (int bj = 0; bj < 2; ++bj)
#pragma unroll
                    for (int j = 0; j < 8; ++j) ss += xn[bj][j] * xn[bj][j];
                ss += __shfl_xor(ss, 16); ss += __shfl_xor(ss, 32);
                const float rk = rsqrtf(ss * (1.f / 96.f) + 1e-6f);
                const f32x4 c0 = *(const f32x4*)(rope + pos * 8), c1 = *(const f32x4*)(rope + pos * 8 + 4), s0 = *(const f32x4*)(rope + 512 + pos * 8), s1 = *(const f32x4*)(rope + 512 + pos * 8 + 4);
                const float cs[8] = {c0[0], c0[1], c0[2], c0[3], c1[0], c1[1], c1[2], c1[3]}, sn[8] = {s0[0], s0[1], s0[2], s0[3], s1[0], s1[1], s1[2], s1[3]};
                bf16_t* kr = K + (size_t)row * 768 + head * 96;
#pragma unroll
                for (int bj = 0; bj < 2; ++bj) { u32x4 w;
                    w.x = cvt_pk_bf16(xn[bj][0] * gn[bj][0] * rk, xn[bj][1] * gn[bj][1] * rk); w.y = cvt_pk_bf16(xn[bj][2] * gn[bj][2] * rk, xn[bj][3] * gn[bj][3] * rk);
                    w.z = cvt_pk_bf16(xn[bj][4] * gn[bj][4] * rk, xn[bj][5] * gn[bj][5] * rk); w.w = cvt_pk_bf16(xn[bj][6] * gn[bj][6] * rk, xn[bj][7] * gn[bj][7] * rk);
                    *(u32x4*)(kr + bj * 32 + 8 * fq) = w; }
#pragma unroll
                for (int j = 0; j < 8; ++j) { const float cc = lat ? cs[j] : 1.f, sv = lat ? sgn * sn[j] : 0.f; xo[j] = (xo[j] * gr[j] * cc + xp[j] * gp[j] * sv) * rk; }
                u32x4 w; w.x = cvt_pk_bf16(xo[0], xo[1]); w.y = cvt_pk_bf16(xo[2], xo[3]); w.z = cvt_pk_bf16(xo[4], xo[5]); w.w = cvt_pk_bf16(xo[6], xo[7]);
                *(u32x4*)(kr + 64 + 8 * fq) = w;
                __builtin_amdgcn_sched_barrier(0);
            }
    }
};
struct EpiVT {
    static constexpr bool PERM = true;
    bf16_t* VT; const float* SSKV;
    DI void operator()(g8::Acc& acc, const g8::Unit& u, int wr, int wc, int fr, int fq) const {
        asm volatile("" : "+v"(fr), "+v"(fq));
        const int row0 = u.pm * 256 + wr * 64 + fr, col0 = u.pn * 256 + wc * 32 + 8 * fq;
        float rv[2][8];
#pragma unroll
        for (int bj = 0; bj < 2; ++bj) { const f32x4 a = *(const f32x4*)(SSKV + col0 + bj * 128), b = *(const f32x4*)(SSKV + col0 + bj * 128 + 4);
#pragma unroll
            for (int j = 0; j < 4; ++j) { rv[bj][j] = rsqrtf(a[j] * (1.f / 256.f) + 1e-6f); rv[bj][4 + j] = rsqrtf(b[j] * (1.f / 256.f) + 1e-6f); } }
#pragma unroll
        for (int ai = 0; ai < 2; ++ai)
#pragma unroll
            for (int m = 0; m < 4; ++m)
#pragma unroll
                for (int bj = 0; bj < 2; ++bj) { u32x4 w;
                    w.x = cvt_pk_bf16(acc[ai][bj][m][0][0] * rv[bj][0], acc[ai][bj][m][0][1] * rv[bj][1]); w.y = cvt_pk_bf16(acc[ai][bj][m][0][2] * rv[bj][2], acc[ai][bj][m][0][3] * rv[bj][3]);
                    w.z = cvt_pk_bf16(acc[ai][bj][m][1][0] * rv[bj][4], acc[ai][bj][m][1][1] * rv[bj][5]); w.w = cvt_pk_bf16(acc[ai][bj][m][1][2] * rv[bj][6], acc[ai][bj][m][1][3] * rv[bj][7]);
                    *(u32x4*)(VT + (size_t)(row0 + ai * 128 + m * 16) * NROW + col0 + bj * 128) = w; }
    }
};
struct ProbVT {
    const bf16_t* Wv; const bf16_t* ZZ; int G, c;
    DI bool next(int i, g8::Unit& u) const { const int L = i * G + c; if (L >= 144) return false; u.pn = L >> 1; u.pm = L & 1; u.ty = 0; u.e = 0; u.aux = 0; return true; }
    DI void addr(const g8::Unit& u, const int (&R)[2], const int (&C)[2], const int (&Rb)[2], g8::Addr& a) const {
        g8::addr_plain(a, Wv + (size_t)u.pm * 256 * 256, 512u, ZZ + (size_t)u.pn * 256 * 1280 + 768, 2560u, 4, R, C, Rb);
    }
};
DI void phase_qkv(const Params& p, LAS unsigned char* lds, int dry = 0) {
    const int G = gridDim.x, c = blockIdx.x;
    const float* rope = (const float*)(p.ws + WS_ROPE);
    {   ProbPlain P{p.ws + WS_ZZ, p.ws + WS_WUQ, 2560u, 1536u, 64, 3, 12, G, c};
        EpiQ E{(bf16_t*)(p.ws + WS_Q), (const float*)(p.ws + CTL_SSQ), (float*)(p.ws + CTL_HSS), p.in[I_QNGAIN], rope, dry};
        g8::gemm_phase(lds, P, E); }
    {   ProbS5 P{(const bf16_t*)(p.ws + WS_UC), (const bf16_t*)(p.ws + WS_S5WEND), 5, 4, 512u, (size_t)256 * 256, G, (c + 192) % G};
        EpiSend E{(float*)(p.ws + WS_SEND)};
        g8::gemm_phase(lds, P, E); }
    {   ProbPlain P{p.ws + WS_ZZ + 768 * 2, p.ws + WS_WUK, 2560u, 512u, 72, 2, 4, G, (c + 96) % G};
        EpiK E{(bf16_t*)(p.ws + WS_K), (const bf16_t*)(p.ws + WS_ZZ), (const float*)(p.ws + CTL_SSKV), p.in[I_KNGAIN], rope};
        g8::gemm_phase(lds, P, E); }
    {   ProbVT P{(const bf16_t*)(p.ws + WS_WUV), (const bf16_t*)(p.ws + WS_ZZ), G, (c + 240) % G};
        EpiVT E{(bf16_t*)(p.ws + WS_VT), (const float*)(p.ws + CTL_SSKV)};
        g8::gemm_phase(lds, P, E); }
}

DI void s5_carry_scan(const Params& p) {
    const int tid_ = my_tid(); const int lane = tid_ & 63, wave = __builtin_amdgcn_readfirstlane(tid_ >> 6);
    if (wave >= 2) return;
    const int task = blockIdx.x * 2 + wave; if (task >= 512) return;
    const int b = task & 7, g = (task >> 3) & 31, d = task >> 8;
    const f32x2 a16 = *(const f32x2*)((const float*)(p.ws + WS_S5A16) + (size_t)((d * 32 + g) * 64 + lane) * 2);
    const float* S = (const float*)(p.ws + WS_SEND) + (size_t)g * 1280 * 256 + d * 128 + lane * 2;
    bf16_t* Cy = (bf16_t*)(p.ws + WS_UC) + (size_t)g * 1280 * 512 + 256 + d * 128 + lane * 2;
    float hr = 0.f, hi = 0.f;
    for (int blk = 0; blk < 144; blk += 16) {
        f32x2 sv[16]; int rr[16];
#pragma unroll
        for (int k = 0; k < 16; ++k) { const int st = blk + k;
            const int r = st < 16 ? 1024 + b * 16 + (d ? 15 - st : st) : b * 128 + (d ? 143 - st : st - 16);
            rr[k] = r; sv[k] = *(const f32x2*)(S + (size_t)r * 256); }
#pragma unroll
        for (int k = 0; k < 16; ++k) {
            *(unsigned*)(Cy + (size_t)rr[k] * 512) = cvt_pk_bf16(hr, hi);
            const float nr = a16[0] * hr - a16[1] * hi + sv[k][0], ni = a16[0] * hi + a16[1] * hr + sv[k][1];
            hr = nr; hi = ni;
        }
    }
}
DI void phase_attn(const Params& p, LAS unsigned char* lds) {
    s5_carry_scan(p);
    const int tid = my_tid(), lane = tid & 63, wave = __builtin_amdgcn_readfirstlane(tid >> 6), r = lane & 31, hh = lane >> 5;
    const bf16_t* Q = (const bf16_t*)(p.ws + WS_Q); const bf16_t* K = (const bf16_t*)(p.ws + WS_K); const bf16_t* VT = (const bf16_t*)(p.ws + WS_VT);
    const float* HSS = (const float*)(p.ws + CTL_HSS); bf16_t* O = (bf16_t*)(p.ws + WS_MIXCD);
    constexpr int KS = 208, VS = 144, KB = 64 * KS, VB = 64 * VS, BUF = KB + VB;
    for (int L = blockIdx.x; L < 512; L += gridDim.x) {
        const int bh = L >> 3, qt = L & 7, b = bh >> 3, h = bh & 7;
        const int qrow = b * 2048 + qt * 256 + wave * 32 + r;
        const float qs = rsqrtf(HSS[(size_t)qrow * 8 + h] * (1.f / 96.f) + 1e-6f) * (0.10206207261596577f * 1.4426950408889634f);
        bf16x8 qf[6];
#pragma unroll
        for (int ks = 0; ks < 6; ++ks) { const u32x4 v = *(const u32x4*)(Q + (size_t)qrow * 768 + h * 96 + ks * 16 + 8 * hh);
            u32x4 w; w.x = pk_bf16(bf_lo(v.x) * qs, bf_hi(v.x) * qs); w.y = pk_bf16(bf_lo(v.y) * qs, bf_hi(v.y) * qs); w.z = pk_bf16(bf_lo(v.z) * qs, bf_hi(v.z) * qs); w.w = pk_bf16(bf_lo(v.w) * qs, bf_hi(v.w) * qs);
            qf[ks] = __builtin_bit_cast(bf16x8, w); }
        f32x16 ot[2];
#pragma unroll
        for (int i = 0; i < 16; ++i) { ot[0][i] = 0.f; ot[1][i] = 0.f; }
        float mrun = -1.0e30f, lrun = 0.f;
        const int kk0 = tid / 12, kp0 = tid - kk0 * 12, kk1 = (tid + 512) / 12, kp1 = (tid + 512) - kk1 * 12; const bool k2 = tid < 256;
        const int vd = tid >> 3, vp = tid & 7;
        u32x4 sk0, sk1 = (u32x4){0u, 0u, 0u, 0u}, sv;
        auto tokbase = [&](int t) { return t < 4 ? NLAT + b * 256 + t * 64 : b * 2048 + (t - 4) * 64; };
        auto gload = [&](int t) { const int tb = tokbase(t);
            sk0 = *(const u32x4*)(K + (size_t)(tb + kk0) * 768 + h * 96 + kp0 * 8);
            if (k2) sk1 = *(const u32x4*)(K + (size_t)(tb + kk1) * 768 + h * 96 + kp1 * 8);
            sv = *(const u32x4*)(VT + (size_t)(h * 64 + vd) * NROW + tb + vp * 8); };
        auto lstore = [&](int buf) { LAS unsigned char* bp = lds + buf * BUF;
            *(LAS u32x4*)(bp + kk0 * KS + kp0 * 16) = sk0; if (k2) *(LAS u32x4*)(bp + kk1 * KS + kp1 * 16) = sk1;
            *(LAS u32x4*)(bp + KB + vd * VS + vp * 16) = sv; };
        __syncthreads();
        gload(0); lstore(0);
        __syncthreads();
        for (int t = 0; t < 36; ++t) {
            if (t + 1 < 36) gload(t + 1);
            LAS const unsigned char* kb_ = lds + (t & 1) * BUF; LAS const unsigned char* vb_ = kb_ + KB;
            f32x16 st[2];
#pragma unroll
            for (int kb = 0; kb < 2; ++kb) {
#pragma unroll
                for (int i = 0; i < 16; ++i) st[kb][i] = 0.f;
#pragma unroll
                for (int ks = 0; ks < 6; ++ks) { const bf16x8 kf = *(const LAS bf16x8*)(kb_ + (kb * 32 + r) * KS + ks * 32 + hh * 16);
                    st[kb] = __builtin_amdgcn_mfma_f32_32x32x16_bf16(kf, qf[ks], st[kb], 0, 0, 0); }
            }
            float mx = st[0][0];
#pragma unroll
            for (int i = 0; i < 16; ++i) { mx = fmaxf(mx, st[0][i]); mx = fmaxf(mx, st[1][i]); }
            mx = fmaxf(mx, __shfl_xor(mx, 32));
            const float mnew = fmaxf(mrun, mx), alpha = fast_exp2(mrun - mnew);
            mrun = mnew;
            float ps = 0.f;
#pragma unroll
            for (int kb = 0; kb < 2; ++kb)
#pragma unroll
                for (int i = 0; i < 16; ++i) { st[kb][i] = fast_exp2(st[kb][i] - mnew); ps += st[kb][i]; }
            lrun = lrun * alpha + ps;
#pragma unroll
            for (int i = 0; i < 16; ++i) { ot[0][i] *= alpha; ot[1][i] *= alpha; }
#pragma unroll
            for (int kb = 0; kb < 2; ++kb)
#pragma unroll
                for (int s = 0; s < 2; ++s) {
                    u32x4 pw; pw.x = pk_bf16(st[kb][8 * s], st[kb][8 * s + 1]); pw.y = pk_bf16(st[kb][8 * s + 2], st[kb][8 * s + 3]); pw.z = pk_bf16(st[kb][8 * s + 4], st[kb][8 * s + 5]); pw.w = pk_bf16(st[kb][8 * s + 6], st[kb][8 * s + 7]);
                    const bf16x8 pf = __builtin_bit_cast(bf16x8, pw);
#pragma unroll
                    for (int db = 0; db < 2; ++db) {
                        const u32x2 v0 = *(const LAS u32x2*)(vb_ + (db * 32 + r) * VS + (kb * 32 + 16 * s + 4 * hh) * 2), v1 = *(const LAS u32x2*)(vb_ + (db * 32 + r) * VS + (kb * 32 + 16 * s + 8 + 4 * hh) * 2);
                        const u32x4 vw = (u32x4){v0.x, v0.y, v1.x, v1.y};
                        ot[db] = __builtin_amdgcn_mfma_f32_32x32x16_bf16(__builtin_bit_cast(bf16x8, vw), pf, ot[db], 0, 0, 0);
                    }
                }
            if (t + 1 < 36) lstore((t + 1) & 1);
            __syncthreads();
        }
        const float linv = 1.f / (lrun + __shfl_xor(lrun, 32));
#pragma unroll
        for (int db = 0; db < 2; ++db)
#pragma unroll
            for (int g4 = 0; g4 < 4; ++g4) { u32x2 w; w.x = pk_bf16(ot[db][4 * g4] * linv, ot[db][4 * g4 + 1] * linv); w.y = pk_bf16(ot[db][4 * g4 + 2] * linv, ot[db][4 * g4 + 3] * linv);
                *(u32x2*)(O + (size_t)qrow * 1024 + 512 + h * 64 + db * 32 + 8 * g4 + 4 * hh) = w; }
    }
}

struct EpiY {
    static constexpr bool PERM = true;
    bf16_t* Gb;
    DI void operator()(g8::Acc& acc, const g8::Unit& u, int wr, int wc, int fr, int fq) const {
        asm volatile("" : "+v"(fr), "+v"(fq));
        const int r0 = u.pm * 256 + wr * 64 + fr;
#pragma unroll
        for (int ai = 0; ai < 2; ++ai)
#pragma unroll
            for (int m = 0; m < 4; ++m)
#pragma unroll
                for (int bj = 0; bj < 2; ++bj) { const int col = bj * 128 + wc * 32 + 8 * fq, tok = (r0 + ai * 128 + m * 16) * 16 + (col >> 4);
                    g8::store8<1>(Gb + (size_t)tok * 512 + u.e * 16 + (col & 15), acc[ai][bj][m][0], acc[ai][bj][m][1]); __builtin_amdgcn_sched_barrier(0); }
    }
};
struct EpiGlu {
    static constexpr bool PERM = true;
    const bf16_t* Gb; bf16_t* MX;
    DI void operator()(g8::Acc& acc, const g8::Unit& u, int wr, int wc, int fr, int fq) const {
        asm volatile("" : "+v"(fr), "+v"(fq));
        const int row0 = u.pm * 256 + wr * 64 + fr, col0 = u.pn * 256 + wc * 32 + 8 * fq;
#pragma unroll
        for (int ai = 0; ai < 2; ++ai)
#pragma unroll
            for (int m = 0; m < 4; ++m)
#pragma unroll
                for (int bj = 0; bj < 2; ++bj) { const int row = row0 + ai * 128 + m * 16, col = col0 + bj * 128;
                    const u32x4 gv = *(const u32x4*)(Gb + (size_t)row * 512 + col);
                    const float gx[8] = {bf_lo(gv.x), bf_hi(gv.x), bf_lo(gv.y), bf_hi(gv.y), bf_lo(gv.z), bf_hi(gv.z), bf_lo(gv.w), bf_hi(gv.w)};
                    float x[8];
#pragma unroll
                    for (int j = 0; j < 4; ++j) { x[j] = gx[j] * sigm_f(acc[ai][bj][m][0][j]); x[4 + j] = gx[4 + j] * sigm_f(acc[ai][bj][m][1][j]); }
                    u32x4 w; w.x = cvt_pk_bf16(x[0], x[1]); w.y = cvt_pk_bf16(x[2], x[3]); w.z = cvt_pk_bf16(x[4], x[5]); w.w = cvt_pk_bf16(x[6], x[7]);
                    *(u32x4*)(MX + (size_t)row * 1024 + col) = w; __builtin_amdgcn_sched_barrier(0); }
    }
};
DI void phase_s5y(const Params& p, LAS unsigned char* lds) {
    ProbS5 P{(const bf16_t*)(p.ws + WS_UC), (const bf16_t*)(p.ws + WS_S5WY), 4, 8, 1024u, (size_t)256 * 512, (int)gridDim.x, (int)blockIdx.x};
    EpiY E{(bf16_t*)(p.ws + WS_G)};
    g8::gemm_phase(lds, P, E);
}
DI void phase_glu(const Params& p, LAS unsigned char* lds) {
    ProbPlain P{p.ws + WS_G, p.ws + WS_WGLU, 1024u, 1024u, 64, 2, 8, (int)gridDim.x, (int)blockIdx.x};
    EpiGlu E{(const bf16_t*)(p.ws + WS_G), (bf16_t*)(p.ws + WS_MIXCD)};
    g8::gemm_phase(lds, P, E);
}
DI void phase_cdout(const Params& p, LAS unsigned char* lds) {
    ProbPlain P{p.ws + WS_MIXCD, p.ws + WS_WCDOUT, 2048u, 2048u, 64, 4, 16, (int)gridDim.x, (int)blockIdx.x};
    EpiResid E{p.out, (const float*)(p.ws + WS_XC), p.out, (float*)(p.ws + WS_XC), (const float*)(p.ws + WS_MOD) + 9 * 6144 + 2048, (float*)(p.ws + CTL_SS2), 0};
    g8::gemm_phase(lds, P, E);
}
DI Params load_params(LAS unsigned char* lds) {
    LAS const unsigned long long* tab = (LAS const unsigned long long*)(lds + LDS_MISC + 512);
    Params q;
#pragma unroll
    for (int i = 0; i < 37; ++i) { const unsigned long long v = tab[i]; q.in[i] = (const float*)(((unsigned long long)(unsigned)__builtin_amdgcn_readfirstlane((int)(v >> 32)) << 32) | (unsigned)__builtin_amdgcn_readfirstlane((int)v)); }
    { const unsigned long long v = tab[37]; q.out = (float*)(((unsigned long long)(unsigned)__builtin_amdgcn_readfirstlane((int)(v >> 32)) << 32) | (unsigned)__builtin_amdgcn_readfirstlane((int)v)); }
    { const unsigned long long v = tab[38]; q.ws = (unsigned char*)(((unsigned long long)(unsigned)__builtin_amdgcn_readfirstlane((int)(v >> 32)) << 32) | (unsigned)__builtin_amdgcn_readfirstlane((int)v)); }
    return q;
}
#define PHASE(call) do { const Params q = load_params(lds); call; } while (0)
#define GRIDBAR() do { XcdBarrier bar; bar.bar = barw; bar.x = xcc; bar.st = (volatile LAS unsigned*)(lds + LDS_MISC); xcd_barrier(bar); } while (0)
__global__ __launch_bounds__(512, 2) void k_fwd(Params pdummy) {
    extern __shared__ __attribute__((aligned(16))) unsigned char shm[];
    LAS unsigned char* lds = (LAS unsigned char*)shm;
    {   const int tid = my_tid();
        const unsigned long long* ka = (const unsigned long long*)__builtin_amdgcn_kernarg_segment_ptr();
        if (tid < 39) ((LAS unsigned long long*)(lds + LDS_MISC + 512))[tid] = ka[tid];
        if (tid == 0) *(LAS u32x4*)(lds + LDS_MISC) = (u32x4){0u, 0u, 0u, 0u};
    }
    __syncthreads();
    unsigned* barw; unsigned xcc;
    {   const Params q = load_params(lds); barw = (unsigned*)(q.ws + CTL_BAR);
        const XcdBarrier b0 = xcd_barrier_post(barw, (volatile LAS unsigned*)(lds + LDS_MISC)); xcc = b0.x; }
    PHASE(phase_p0(q, lds));          GRIDBAR();
    PHASE(phase_p1(q));               GRIDBAR();
    PHASE(phase_p2(q, lds));          GRIDBAR();
    PHASE(phase_p3(q, lds));          GRIDBAR();
    PHASE(phase_p4(q, lds));          GRIDBAR();
    PHASE(phase_router<0>(q, lds));   GRIDBAR();
    PHASE(phase_moe1<0>(q, lds));     GRIDBAR();
    PHASE(phase_moe2<0>(q, lds));     GRIDBAR();
    PHASE(phase_combine<0>(q, lds));  GRIDBAR();
    PHASE(phase_cdin(q, lds));        GRIDBAR();
    PHASE(phase_qkv(q, lds));         GRIDBAR();
    PHASE(phase_attn(q, lds));        GRIDBAR();
    PHASE(phase_s5y(q, lds));         GRIDBAR();
    PHASE(phase_glu(q, lds));         GRIDBAR();
    PHASE(phase_cdout(q, lds));       GRIDBAR();
    PHASE(phase_router<1>(q, lds));   GRIDBAR();
    PHASE(phase_moe1<1>(q, lds));     GRIDBAR();
    PHASE(phase_moe2<1>(q, lds));     GRIDBAR();
    PHASE(phase_combine<1>(q, lds));
    (void)pdummy;
}
static const int kDynLds = 160 * 1024;
extern "C" void kernel_launch(void* const* d_in, const int* in_sizes, int n_in, void* d_out, int out_size, void* d_ws, size_t ws_size, hipStream_t stream) {
    Params p{};
    for (int i = 0; i < 37; ++i) p.in[i] = (const float*)d_in[i];
    p.out = (float*)d_out; p.ws = (unsigned char*)d_ws;
    (void)ws_size; (void)in_sizes; (void)n_in; (void)out_size;
    static int grid = 0;
    if (!grid) {
        int dev = 0, cus = 0, per_cu = 0;
        (void)hipGetDevice(&dev);
        (void)hipDeviceGetAttribute(&cus, hipDeviceAttributeMultiprocessorCount, dev);
        (void)hipFuncSetAttribute((const void*)k_fwd, hipFuncAttributeMaxDynamicSharedMemorySize, kDynLds);
        (void)hipOccupancyMaxActiveBlocksPerMultiprocessor(&per_cu, (const void*)k_fwd, 512, kDynLds);
        grid = cus > 0 ? cus : 256;
        if (per_cu < 1) fprintf(stderr, "kernel_launch: occupancy query reports %d workgroups per CU\n", per_cu);
    }
    (void)hipMemsetAsync(d_ws, 0, CTL_BYTES, stream);
    hipLaunchKernelGGL(k_fwd, dim3(grid), dim3(512), kDynLds, stream, p);
}
```
